# Optimizing an MI355X kernel written in HIP

```python
import math
import jax, jax.numpy as jnp
from jax import lax
import numpy as np


D_MODEL = 4096
BATCH = 2
SEQ = 8192
DEPTH = 2

CTX_LEN = 256
GRID_W = 64
N_MIXERS = 2
EXPAND = 2
D_INNER = EXPAND * D_MODEL
S5_GROUP = 16
S5_STATE = 64
S5_GROUPS = D_INNER // S5_GROUP
S5_CHUNK = 128
DT_MIN = 1e-3
DT_MAX = 1e-1
POOL_WINDOWS = (2, 4, 8, 16)
POOL_GROUPS = len(POOL_WINDOWS)
POOL_DIM = D_INNER // POOL_GROUPS
N_S5 = (DEPTH + 1) // 2
N_POOL = DEPTH // 2
RMS_EPS = 1e-6

kernel_name = 'hybrid_s5_pool_prefix_trunk'


def rmsnorm(x, w):
    xf = x.astype(jnp.float32)
    y = xf * lax.rsqrt(jnp.mean(xf * xf, axis=-1, keepdims=True) + RMS_EPS)
    return (y * w.astype(jnp.float32)).astype(x.dtype)


def adaln(cond, w, b):
    m = jax.nn.silu(cond) @ w + b
    return jnp.split(m, 3, axis=-1)


def s5_discretize(lam_re, lam_im, log_step, b_re, b_im, c_re, c_im):
    f32 = lambda a: a.astype(jnp.float32)
    lam = lax.complex(f32(lam_re), f32(lam_im))
    dt = jnp.exp(f32(log_step))[:, None]
    lam_bar = jnp.exp(lam * dt)
    b = lax.complex(f32(b_re), f32(b_im))
    b_bar = ((lam_bar - 1.0) / lam)[..., None] * b
    cm = lax.complex(f32(c_re), f32(c_im))
    return lam_bar, b_bar, cm


def _linear_recurrence(e1, e2):
    a1, b1 = e1
    a2, b2 = e2
    return a1 * a2, a2 * b1 + b2


def s5_scan(u, h0, lam_bar, b_bar, cm, reverse):
    bsz, length, _ = u.shape
    chunk = min(S5_CHUNK, length)
    n_chunks = length // chunk
    uf = u.astype(jnp.float32)
    if reverse:
        uf = uf[:, ::-1]
    ub = uf.reshape(bsz, n_chunks, chunk, S5_GROUPS, S5_GROUP).transpose(1, 0, 2, 3, 4)

    def step(h, u_blk):
        bu = jnp.einsum('gpj,btgj->btgp', b_bar, u_blk.astype(jnp.complex64))
        bu = bu.at[:, 0].add(lam_bar * h)
        a = jnp.broadcast_to(lam_bar, bu.shape)
        _, s = lax.associative_scan(_linear_recurrence, (a, bu), axis=1)
        y = jnp.einsum('gjp,btgp->btgj', cm, s).real
        return s[:, -1], y

    h_final, ys = lax.scan(step, h0, ub)
    y = ys.transpose(1, 0, 2, 3, 4).reshape(bsz, length, D_INNER)
    if reverse:
        y = y[:, ::-1]
    return y, h_final


def s5_bidirectional(u, uc, lam_re, lam_im, log_step, b_re, b_im, c_re, c_im):
    y_lat = 0.0
    y_ctx = 0.0
    for d, rev in enumerate((False, True)):
        lam_bar, b_bar, cm = s5_discretize(lam_re[d], lam_im[d], log_step[d],
                                           b_re[d], b_im[d], c_re[d], c_im[d])
        h0 = jnp.zeros((u.shape[0], S5_GROUPS, S5_STATE), jnp.complex64)
        yc, hc = s5_scan(uc, h0, lam_bar, b_bar, cm, rev)
        yl, _ = s5_scan(u, hc, lam_bar, b_bar, cm, rev)
        y_lat = y_lat + yl
        y_ctx = y_ctx + yc
    return y_lat, y_ctx


def s5_readout(y_scan, u, d_skip, w_glu, b_glu):
    y = y_scan + d_skip.astype(jnp.float32) * u.astype(jnp.float32)
    y = jax.nn.gelu(y).astype(u.dtype)
    return y * jax.nn.sigmoid(y @ w_glu + b_glu)


def window_bounds(n, w):
    pos = jnp.arange(n)
    return jnp.clip(pos - w // 2, 0, n), jnp.clip(pos + w - w // 2, 0, n)


def pool_group_deltas(u, on_grid):
    uf = u.astype(jnp.float32)
    bsz, length, _ = uf.shape
    deltas = []
    if on_grid:
        rows = length // GRID_W
        g = uf.reshape(bsz, rows, GRID_W, D_INNER)
        sat = jnp.pad(jnp.cumsum(jnp.cumsum(g, axis=1), axis=2), ((0, 0), (1, 0), (1, 0), (0, 0)))
        for k, w in enumerate(POOL_WINDOWS):
            s = sat[..., k * POOL_DIM:(k + 1) * POOL_DIM]
            r_lo, r_hi = window_bounds(rows, w)
            c_lo, c_hi = window_bounds(GRID_W, w)
            corner = lambda ri, ci: s[:, ri][:, :, ci]
            total = corner(r_hi, c_hi) - corner(r_lo, c_hi) - corner(r_hi, c_lo) + corner(r_lo, c_lo)
            count = ((r_hi - r_lo)[:, None] * (c_hi - c_lo)[None, :]).astype(jnp.float32)
            mean = (total / count[None, :, :, None]).reshape(bsz, length, POOL_DIM)
            deltas.append(mean - uf[..., k * POOL_DIM:(k + 1) * POOL_DIM])
    else:
        p = jnp.pad(jnp.cumsum(uf, axis=1), ((0, 0), (1, 0), (0, 0)))
        for k, w in enumerate(POOL_WINDOWS):
            sl = slice(k * POOL_DIM, (k + 1) * POOL_DIM)
            lo, hi = window_bounds(length, w)
            mean = (p[:, hi, sl] - p[:, lo, sl]) / (hi - lo).astype(jnp.float32)[None, :, None]
            deltas.append(mean - uf[..., sl])
    return deltas


def pool_mixer(u, on_grid, w_groups, scale):
    deltas = pool_group_deltas(u, on_grid)
    y = jnp.concatenate([d.astype(u.dtype) @ w_groups[k] for k, d in enumerate(deltas)], axis=-1)
    return y * scale


def setup_inputs(seed: int = 0) -> dict:
    key = jax.random.key(seed)
    ks = jax.random.split(key, 24)
    nrm = jax.random.normal
    G, P, J, E, D = S5_GROUPS, S5_STATE, S5_GROUP, D_INNER, D_MODEL
    lam_im_init = jnp.pi * jnp.arange(P, dtype=jnp.float32)
    return {
        'x': nrm(ks[0], (BATCH, SEQ, D), jnp.float32),
        'c': nrm(ks[1], (BATCH, D), jnp.float32),
        'ctx': nrm(ks[2], (BATCH, CTX_LEN, D), jnp.float32),
        'c_ctx': nrm(ks[3], (D,), jnp.float32),
        'norm_w': 1.0 + 0.01 * nrm(ks[4], (DEPTH, D), jnp.float32),
        'w_ada': nrm(ks[5], (DEPTH, D, 3 * D), jnp.float32) * D ** -0.5,
        'b_ada': 0.01 * nrm(ks[6], (DEPTH, 3 * D), jnp.float32),
        'w_in': nrm(ks[7], (DEPTH, D, 2 * E), jnp.float32) * D ** -0.5,
        'w_out': nrm(ks[8], (DEPTH, E, D), jnp.float32) * E ** -0.5,
        's5_lam_re': -0.5 + 0.01 * nrm(ks[9], (N_S5, 2, G, P), jnp.float32),
        's5_lam_im': lam_im_init + 0.01 * nrm(ks[10], (N_S5, 2, G, P), jnp.float32),
        's5_log_step': jax.random.uniform(ks[11], (N_S5, 2, G), jnp.float32,
                                          minval=math.log(DT_MIN), maxval=math.log(DT_MAX)),
        's5_b_re': nrm(ks[12], (N_S5, 2, G, P, J), jnp.float32) * (2 * J) ** -0.5,
        's5_b_im': nrm(ks[13], (N_S5, 2, G, P, J), jnp.float32) * (2 * J) ** -0.5,
        's5_c_re': nrm(ks[14], (N_S5, 2, G, J, P), jnp.float32) * P ** -0.5,
        's5_c_im': nrm(ks[15], (N_S5, 2, G, J, P), jnp.float32) * P ** -0.5,
        's5_d': nrm(ks[16], (N_S5, E), jnp.float32),
        's5_w_glu': nrm(ks[17], (N_S5, E, E), jnp.float32) * E ** -0.5,
        's5_b_glu': 0.01 * nrm(ks[18], (N_S5, E), jnp.float32),
        'pool_w': nrm(ks[19], (N_POOL, POOL_GROUPS, POOL_DIM, POOL_DIM), jnp.float32) * POOL_DIM ** -0.5,
        'pool_scale': 1.0 + 0.02 * nrm(ks[20], (N_POOL, E), jnp.float32),
        'final_norm_w': 1.0 + 0.01 * nrm(ks[21], (D,), jnp.float32),
    }


def reference(x, c, ctx, c_ctx, norm_w, w_ada, b_ada, w_in, w_out,
              s5_lam_re, s5_lam_im, s5_log_step, s5_b_re, s5_b_im, s5_c_re, s5_c_im,
              s5_d, s5_w_glu, s5_b_glu, pool_w, pool_scale, final_norm_w):
    for i in range(DEPTH):
        kind = i % N_MIXERS
        j = i // N_MIXERS
        ctx_later = any(l % N_MIXERS == 0 for l in range(i + 1, DEPTH))
        shift, scale, gate = adaln(c, w_ada[i], b_ada[i])
        h = rmsnorm(x, norm_w[i]) * (1.0 + scale[:, None]) + shift[:, None]
        u, z = jnp.split(h @ w_in[i], 2, axis=-1)
        if kind == 0 or ctx_later:
            shift_c, scale_c, gate_c = adaln(c_ctx, w_ada[i], b_ada[i])
            hc = rmsnorm(ctx, norm_w[i]) * (1.0 + scale_c) + shift_c
            uc, zc = jnp.split(hc @ w_in[i], 2, axis=-1)
        if kind == 0:
            y_lat_scan, y_ctx_scan = s5_bidirectional(
                u, uc, s5_lam_re[j], s5_lam_im[j], s5_log_step[j],
                s5_b_re[j], s5_b_im[j], s5_c_re[j], s5_c_im[j])
            y_lat = s5_readout(y_lat_scan, u, s5_d[j], s5_w_glu[j], s5_b_glu[j])
            if ctx_later:
                y_ctx = s5_readout(y_ctx_scan, uc, s5_d[j], s5_w_glu[j], s5_b_glu[j])
        else:
            y_lat = pool_mixer(u, True, pool_w[j], pool_scale[j])
            if ctx_later:
                y_ctx = pool_mixer(uc, False, pool_w[j], pool_scale[j])
        x = x + gate[:, None] * ((y_lat * jax.nn.silu(z)) @ w_out[i])
        if ctx_later:
            ctx = ctx + gate_c * ((y_ctx * jax.nn.silu(zc)) @ w_out[i])
    return rmsnorm(x, final_norm_w)
```

```cpp
#include <hip/hip_runtime.h>
#include <cstdio>
#include <cstdint>

#ifndef MK_N_LAUNCHES
#define MK_N_LAUNCHES 1
#endif
constexpr int N_PHASES = 12;

constexpr int DM = 4096, NB = 2, SEQ = 8192, CTXL = 256, EI = 8192, NG = 512, NP = 64, NJ = 16;
constexpr int M = NB * SEQ;
constexpr int MC = NB * CTXL;
constexpr int MT = M + MC;
constexpr float RMS_EPS = 1e-6f;
constexpr int NWAVES = 8;
constexpr int NGEMM_P2 = 216;

constexpr size_t MiB = 1u << 20;
constexpr size_t WS_CTL = 0, CTL_ZERO_BYTES = 64 * 1024;
constexpr size_t WS_MODP = 1 * MiB;
constexpr size_t WS_S5B = 2 * MiB;
constexpr size_t WS_S5C = 10 * MiB;
constexpr size_t WS_S5K = 18 * MiB;
constexpr size_t WS_S5L = 20 * MiB;
constexpr size_t WS_WIN0 = 24 * MiB, WS_WIN1 = 152 * MiB, WS_WGLU = 280 * MiB, WS_WOUT0 = 408 * MiB, WS_WOUT1 = 472 * MiB, WS_WPOOL = 536 * MiB;
constexpr size_t WS_XN = 568 * MiB;
constexpr size_t WS_U = 700 * MiB;
constexpr size_t WS_SZ = 964 * MiB;
constexpr size_t WS_YA = 1220 * MiB;
constexpr size_t WS_X1 = 1476 * MiB;
constexpr size_t WS_X2 = 1604 * MiB;
constexpr size_t WS_UCP = 1732 * MiB;
constexpr size_t WS_YA8 = 1796 * MiB;
constexpr size_t WS_RS = 21 * MiB;
constexpr size_t WS_END = 1924 * MiB;
constexpr int CW_BAR = 4096;

constexpr int RING_BYTES = 131072;
constexpr int MISC_OFF = RING_BYTES;
constexpr int LDS_BYTES = 147456;

#define GAS __attribute__((address_space(1)))
#define LAS __attribute__((address_space(3)))
typedef unsigned short bf16;
typedef short bf16x8 __attribute__((ext_vector_type(8)));
typedef float f32x4 __attribute__((ext_vector_type(4)));
typedef float f32x16 __attribute__((ext_vector_type(16)));
typedef float f32x2 __attribute__((ext_vector_type(2)));
typedef unsigned u32x4 __attribute__((ext_vector_type(4)));
typedef unsigned u32x2 __attribute__((ext_vector_type(2)));
typedef int i32x4 __attribute__((ext_vector_type(4)));
typedef int i32x8 __attribute__((ext_vector_type(8)));
typedef short s16x2 __attribute__((ext_vector_type(2)));
#ifndef Q8_L0
#define Q8_L0 1
#endif
#ifndef Q8_L1
#define Q8_L1 0
#endif
constexpr float WIN8_KSIG = 4.8f, WG8_KSIG = 5.25f;
constexpr size_t WS_QR = 23 * MiB + 512 * 1024;
constexpr float YA8_R = 14.0f, Q8 = 32767.0f / 256.0f, Q8v = Q8;
__device__ __forceinline__ unsigned pack_i8x4(float x0, float x1, float x2, float x3, float inv_r) {
    s16x2 p = __builtin_amdgcn_cvt_pknorm_i16(x0 * inv_r, x1 * inv_r), q = __builtin_amdgcn_cvt_pknorm_i16(x2 * inv_r, x3 * inv_r); const s16x2 r = {128, 128};
    p = __builtin_elementwise_add_sat(p, r); q = __builtin_elementwise_add_sat(q, r);
    return __builtin_amdgcn_perm(__builtin_bit_cast(unsigned, q), __builtin_bit_cast(unsigned, p), 0x07050301u); }

__device__ __forceinline__ unsigned cvt_pk_bf16(float lo, float hi) { unsigned r; asm volatile("v_cvt_pk_bf16_f32 %0, %1, %2" : "=v"(r) : "v"(lo), "v"(hi)); return r; }
__device__ __forceinline__ unsigned cvt_pk_bf16_mfma(float lo, float hi) { unsigned r; asm volatile("s_nop 7\n\ts_nop 4\n\tv_cvt_pk_bf16_f32 %0, %1, %2" : "=v"(r) : "v"(lo), "v"(hi)); return r; }
__device__ __forceinline__ float bf_lo(unsigned w) { return __uint_as_float(w << 16); }
__device__ __forceinline__ float bf_hi(unsigned w) { return __uint_as_float(w & 0xffff0000u); }
__device__ __forceinline__ float fast_sigmoid(float x) { return __builtin_amdgcn_rcpf(1.0f + __builtin_amdgcn_exp2f(-1.4426950408889634f * x)); }
__device__ __forceinline__ float silu_f(float x) { return x * fast_sigmoid(x); }
__device__ __forceinline__ float gelu_tanh(float x) { const float z = x * (1.5957691216057308f + 0.07135481627260025f * x * x); return x * fast_sigmoid(z); }
__device__ __forceinline__ int lane_id_asm() { int l; asm volatile("v_mbcnt_lo_u32_b32 %0, -1, 0\n\tv_mbcnt_hi_u32_b32 %0, -1, %0" : "=v"(l)); return l; }
__device__ __forceinline__ float wave_sum(float v) {
#pragma unroll
    for (int o = 1; o < 64; o <<= 1) v += __shfl_xor(v, o);
    return v;
}

namespace pg8 {
#define PG8_LAS __attribute__((address_space(3)))
constexpr int BM = 256, BK = 64, HALF = 128, HTB = HALF * BK * 2, STAGE_BYTES = 8 * HTB, NXCD = 8, WGM = 8;
__host__ __device__ __forceinline__ int lds_byte(int r, int c) { const int st = (r >> 4) * 2 + (c >> 5), rr = r & 15, cc = c & 31, ob = rr * 64 + cc * 2; return st * 1024 + (ob ^ (((ob >> 9) & 1) << 5)); }
__host__ __device__ __forceinline__ void stage_rc(int b, int& R, int& C) { const int st = b / 1024, sb = b % 1024, swz = sb ^ (((sb >> 9) & 1) << 5); R = (st >> 1) * 16 + swz / 64; C = (st & 1) * 32 + (swz % 64) / 2; }
__host__ __device__ __forceinline__ int perm32(int rho) { const int n = rho >> 4, i = rho & 15; return 8 * (i >> 2) + 4 * n + (i & 3); }

struct Unit { int pm, pn, grp; };
struct Gemm { const bf16* A; const bf16* Bt; int lda, ldb, K; size_t a_gs, b_gs; int a_gm; };

__device__ __forceinline__ void static_unit(int L, int nM, int nN, int& pm, int& pn) {
    if (nN >= 16) {
        const int blk = L >> 8, within = L & 255, xs = within & 7, off = within >> 3, nJ = nN >> 4;
        const int I = blk / nJ, jj = blk - I * nJ, J = (I & 1) ? nJ - 1 - jj : jj;
        pm = 16 * I + 8 * (xs & 1) + (off & 7); pn = 16 * J + 4 * (xs >> 1) + (off >> 3);
        return;
    }
    if (nN == 8) {
        const int blk = L >> 8, within = L & 255, xs = within & 7, off = within >> 3;
        pm = 32 * blk + 8 * (xs & 3) + (off & 7); pn = 4 * (xs >> 2) + (off >> 3);
        return;
    }
    const int nwg = nM * nN; int wgid = L;
    { const int q = nwg / NXCD, r = nwg % NXCD, xcd = wgid % NXCD, off = wgid / NXCD; wgid = (xcd < r ? xcd * (q + 1) : r * (q + 1) + (xcd - r) * q) + off; }
    const int nig = WGM * nN, gid = wgid / nig, fm = gid * WGM, gsz = (nM - fm) < WGM ? (nM - fm) : WGM;
    pm = fm + ((wgid % nig) % gsz); pn = (wgid % nig) / gsz;
}
struct StaticOrder {
    int nM, nN, G, c;
    __device__ __forceinline__ bool next(int i, Unit& u) const { const int L = i * G + c; if (L >= nM * nN) return false; static_unit(L, nM, nN, u.pm, u.pn); u.grp = 0; return true; }
};
struct CtxOrder {
    int G, c;
    __device__ __forceinline__ bool next(int i, Unit& u) const { const int L = i * G + c; if (L >= 256) return false; const int cu = L >> 2; u.grp = L & 3; u.pm = 64 + (cu >> 5); u.pn = cu & 31; return true; }
};
struct PoolOrder {
    int G, c;
    __device__ __forceinline__ bool next(int i, Unit& u) const { const int L = i * G + c; if (L >= 2048) return false; u.grp = L >> 9; static_unit(L & 511, 64, 8, u.pm, u.pn); return true; }
};

template <bool Q8>
struct EpiInProj {
    static constexpr bool PERM = true, I8 = Q8;
    bf16* U; bf16* SZ; int gm; const float* rowscale; const float* qr;
    __device__ __forceinline__ void operator()(const f32x4 (&acc)[2][2][4][2], const Unit& u, int wr, int wc, int fr, int fq) const {
        const int row0 = u.pm * BM + wr * 64 + fr; const bool isz = u.pn >= 32;
        bf16* base = isz ? SZ : U; const int col0 = (isz ? u.pn - 32 : u.pn) * BM + wc * 32 + 8 * fq;
        const bool g_ = gm && !isz;
#pragma unroll
        for (int ai = 0; ai < 2; ++ai)
#pragma unroll
            for (int m = 0; m < 4; ++m) { const int row = row0 + ai * HALF + m * 16;
                bf16* rowp = g_ ? base + ((size_t)((row >> 13) * NG + (col0 >> 4)) * SEQ + (row & (SEQ - 1))) * 16 + (col0 & 15) : base + (size_t)row * EI + col0;
                const int bjs = g_ ? 8 * SEQ * 16 : HALF;
                float dq = 1.0f; if (Q8) dq = rowscale[(size_t)row * 32] * (qr[0] * (1.0f / ::Q8));
#pragma unroll
                for (int bj = 0; bj < 2; ++bj) { f32x4 v0 = acc[ai][bj][m][0], v1 = acc[ai][bj][m][1];
                    if (Q8) { const i32x4 q0 = __builtin_bit_cast(i32x4, v0), q1 = __builtin_bit_cast(i32x4, v1);
                        v0 = (f32x4){(float)q0[0], (float)q0[1], (float)q0[2], (float)q0[3]} * dq; v1 = (f32x4){(float)q1[0], (float)q1[1], (float)q1[2], (float)q1[3]} * dq; }
                    if (isz) {
#pragma unroll
                        for (int j = 0; j < 4; ++j) { v0[j] = silu_f(v0[j]); v1[j] = silu_f(v1[j]); } }
                    u32x4 w; w.x = cvt_pk_bf16(v0[0], v0[1]); w.y = cvt_pk_bf16(v0[2], v0[3]); w.z = cvt_pk_bf16(v1[0], v1[1]); w.w = cvt_pk_bf16(v1[2], v1[3]);
                    if (isz) __builtin_nontemporal_store(w, (u32x4*)(rowp + (size_t)bj * bjs)); else *(u32x4*)(rowp + (size_t)bj * bjs) = w; }
                asm volatile("" ::: "memory"); }
    }
};
template <bool Q8>
struct EpiCtx {
    static constexpr bool PERM = false, I8 = Q8;
    float* P; const float* rowscale; const float* qr;
    __device__ __forceinline__ void operator()(const f32x4 (&acc)[2][2][4][2], const Unit& u, int wr, int wc, int fr, int fq) const {
        const int row0 = (u.pm - 64) * BM + wr * 64 + fr, col0 = u.pn * BM + wc * 32 + 4 * fq; float* base = P + (size_t)u.grp * MC * EI;
#pragma unroll
        for (int ai = 0; ai < 2; ++ai)
#pragma unroll
            for (int m = 0; m < 4; ++m) { const int row = row0 + ai * HALF + m * 16; float* rowp = base + (size_t)row * EI + col0;
                float dq = 1.0f; if (Q8) dq = rowscale[(size_t)(M + row) * 32] * (qr[0] * (1.0f / ::Q8));
#pragma unroll
                for (int bj = 0; bj < 2; ++bj)
#pragma unroll
                    for (int n = 0; n < 2; ++n) { f32x4 v = acc[ai][bj][m][n];
                        if (Q8) { const i32x4 q = __builtin_bit_cast(i32x4, v); v = (f32x4){(float)q[0], (float)q[1], (float)q[2], (float)q[3]} * dq; }
                        *(f32x4*)(rowp + bj * HALF + n * 16) = v; } }
    }
};
struct EpiGlu {
    static constexpr bool PERM = true, I8 = true;
    const bf16* YA; const bf16* SZ; bf16* V; const float* bias; const float* qr;
    __device__ __forceinline__ void operator()(const f32x4 (&acc)[2][2][4][2], const Unit& u, int wr, int wc, int fr, int fq) const {
        const int row0 = u.pm * BM + wr * 64 + fr, col0 = u.pn * BM + wc * 32 + 8 * fq;
        const float GATE_DEQ = YA8_R * qr[1] * (1.0f / (::Q8 * ::Q8));
        f32x4 bv[2][2];
#pragma unroll
        for (int bj = 0; bj < 2; ++bj)
#pragma unroll
            for (int n = 0; n < 2; ++n) bv[bj][n] = *(const f32x4*)(bias + col0 + bj * HALF + 4 * n);
#pragma unroll
        for (int ai = 0; ai < 2; ++ai)
#pragma unroll
            for (int m = 0; m < 4; ++m) { const int row = row0 + ai * HALF + m * 16; const size_t off = (size_t)row * EI + col0;
                const size_t offy = ((size_t)((row >> 13) * NG + (col0 >> 4)) * SEQ + (row & (SEQ - 1))) * 16 + (col0 & 15);
#pragma unroll
                for (int bj = 0; bj < 2; ++bj) { const u32x4 yv = __builtin_nontemporal_load((const u32x4*)(YA + offy + (size_t)bj * 8 * SEQ * 16)), zv = __builtin_nontemporal_load((const u32x4*)(SZ + off + bj * HALF));
                    const i32x4 q0 = __builtin_bit_cast(i32x4, acc[ai][bj][m][0]), q1 = __builtin_bit_cast(i32x4, acc[ai][bj][m][1]);
                    const f32x4 g0 = (f32x4){(float)q0[0], (float)q0[1], (float)q0[2], (float)q0[3]} * GATE_DEQ + bv[bj][0], g1 = (f32x4){(float)q1[0], (float)q1[1], (float)q1[2], (float)q1[3]} * GATE_DEQ + bv[bj][1];
                    float o[8];
                    o[0] = bf_lo(yv.x) * bf_lo(zv.x) * fast_sigmoid(g0[0]); o[1] = bf_hi(yv.x) * bf_hi(zv.x) * fast_sigmoid(g0[1]);
                    o[2] = bf_lo(yv.y) * bf_lo(zv.y) * fast_sigmoid(g0[2]); o[3] = bf_hi(yv.y) * bf_hi(zv.y) * fast_sigmoid(g0[3]);
                    o[4] = bf_lo(yv.z) * bf_lo(zv.z) * fast_sigmoid(g1[0]); o[5] = bf_hi(yv.z) * bf_hi(zv.z) * fast_sigmoid(g1[1]);
                    o[6] = bf_lo(yv.w) * bf_lo(zv.w) * fast_sigmoid(g1[2]); o[7] = bf_hi(yv.w) * bf_hi(zv.w) * fast_sigmoid(g1[3]);
                    u32x4 w; w.x = cvt_pk_bf16(o[0], o[1]); w.y = cvt_pk_bf16(o[2], o[3]); w.z = cvt_pk_bf16(o[4], o[5]); w.w = cvt_pk_bf16(o[6], o[7]);
                    *(u32x4*)(V + off + bj * HALF) = w; } }
    }
};
struct EpiPool {
    static constexpr bool PERM = true, I8 = false;
    const bf16* SZ; bf16* V; const float* scale;
    __device__ __forceinline__ void operator()(const f32x4 (&acc)[2][2][4][2], const Unit& u, int wr, int wc, int fr, int fq) const {
        const int row0 = u.pm * BM + wr * 64 + fr, col0 = u.grp * 2048 + u.pn * BM + wc * 32 + 8 * fq;
        f32x4 sv[2][2];
#pragma unroll
        for (int bj = 0; bj < 2; ++bj)
#pragma unroll
            for (int n = 0; n < 2; ++n) sv[bj][n] = *(const f32x4*)(scale + col0 + bj * HALF + 4 * n);
#pragma unroll
        for (int ai = 0; ai < 2; ++ai)
#pragma unroll
            for (int m = 0; m < 4; ++m) { const size_t off = (size_t)(row0 + ai * HALF + m * 16) * EI + col0;
#pragma unroll
                for (int bj = 0; bj < 2; ++bj) { const u32x4 zv = __builtin_nontemporal_load((const u32x4*)(SZ + off + bj * HALF));
                    const f32x4 g0 = acc[ai][bj][m][0] * sv[bj][0], g1 = acc[ai][bj][m][1] * sv[bj][1];
                    u32x4 w; w.x = cvt_pk_bf16(g0[0] * bf_lo(zv.x), g0[1] * bf_hi(zv.x)); w.y = cvt_pk_bf16(g0[2] * bf_lo(zv.y), g0[3] * bf_hi(zv.y));
                    w.z = cvt_pk_bf16(g1[0] * bf_lo(zv.z), g1[1] * bf_hi(zv.z)); w.w = cvt_pk_bf16(g1[2] * bf_lo(zv.w), g1[3] * bf_hi(zv.w));
                    *(u32x4*)(V + off + bj * HALF) = w; } }
    }
};
template <bool BASE_BF16>
struct EpiOut {
    static constexpr bool PERM = true, I8 = false;
    const void* base; bf16* out; const float* gp0; const float* gp1; const float* gb;
    __device__ __forceinline__ void operator()(const f32x4 (&acc)[2][2][4][2], const Unit& u, int wr, int wc, int fr, int fq) const {
        const int row0 = u.pm * BM + wr * 64 + fr, col0 = u.pn * BM + wc * 32 + 8 * fq; const int b = u.pm >> 5;
        f32x4 gv[2][2];
#pragma unroll
        for (int bj = 0; bj < 2; ++bj)
#pragma unroll
            for (int n = 0; n < 2; ++n) { const int c = col0 + bj * HALF + 4 * n;
                gv[bj][n] = *(const f32x4*)(gp0 + b * 12288 + 8192 + c) + *(const f32x4*)(gp1 + b * 12288 + 8192 + c) + *(const f32x4*)(gb + c); }
#pragma unroll
        for (int ai = 0; ai < 2; ++ai)
#pragma unroll
            for (int m = 0; m < 4; ++m) { const size_t off = (size_t)(row0 + ai * HALF + m * 16) * DM + col0;
#pragma unroll
                for (int bj = 0; bj < 2; ++bj) {
                    f32x4 b0, b1;
                    if (BASE_BF16) { const u32x4 bw = *(const u32x4*)((const bf16*)base + off + bj * HALF); b0 = (f32x4){bf_lo(bw.x), bf_hi(bw.x), bf_lo(bw.y), bf_hi(bw.y)}; b1 = (f32x4){bf_lo(bw.z), bf_hi(bw.z), bf_lo(bw.w), bf_hi(bw.w)}; }
                    else { b0 = __builtin_nontemporal_load((const f32x4*)((const float*)base + off + bj * HALF)); b1 = __builtin_nontemporal_load((const f32x4*)((const float*)base + off + bj * HALF + 4)); }
                    const f32x4 o0 = b0 + gv[bj][0] * acc[ai][bj][m][0], o1 = b1 + gv[bj][1] * acc[ai][bj][m][1];
                    u32x4 w; w.x = cvt_pk_bf16(o0[0], o0[1]); w.y = cvt_pk_bf16(o0[2], o0[3]); w.z = cvt_pk_bf16(o1[0], o1[1]); w.w = cvt_pk_bf16(o1[2], o1[3]);
                    *(u32x4*)(out + off + bj * HALF) = w; }
                if (m & 1) asm volatile("" ::: "memory"); }
    }
};

template <class Epi, class Sched>
__device__ __forceinline__ void gemm_phase(PG8_LAS unsigned char* lds, const Gemm g, const Sched& S, const Epi& E, int wave_) {
    const int wid = wave_, lane = lane_id_asm(), tid = wid * 64 + lane, wr = wid >> 2, wc = wid & 3, fr = lane & 15, fq = lane >> 4;
    const int K = g.K, nt = K / BK;
    unsigned voffA[2], voffB[2];
#pragma unroll
    for (int i = 0; i < 2; ++i) { int R, C; stage_rc(tid * 16 + i * 8192, R, C); const int Rb = Epi::PERM ? ((R & ~31) + perm32(R & 31)) : R;
        voffA[i] = g.a_gm == 2 ? (unsigned)(((C >> 3) * SEQ + R) * 16) : g.a_gm ? (unsigned)(((C >> 4) * SEQ + R) * 32 + (C & 15) * 2) : (unsigned)(R * g.lda + C) * 2u; voffB[i] = (unsigned)(Rb * g.ldb + C) * 2u; }
    const int gmb = g.a_gm == 2 ? 16 : 32;
    const size_t kstep = (size_t)(BK * 2), kstepA = g.a_gm ? (size_t)(128 / gmb) * SEQ * gmb : kstep;
    const size_t hsA = g.a_gm ? (size_t)HALF * gmb : (size_t)HALF * g.lda * 2, hsB = (size_t)HALF * g.ldb * 2;
#define PG8_PANEL_A(u_) (g.a_gm ? (const char*)g.A + ((size_t)((u_).pm >> 5) * NG * SEQ + (size_t)((u_).pm & 31) * BM) * gmb : (const char*)(g.A + (size_t)(u_).grp * g.a_gs) + (size_t)(u_).pm * 2 * hsA)
    const unsigned ldsw = (unsigned)wid * 1024u;
    const int aoff = lds_byte(wr * 64 + fr, fq * 8), boff = lds_byte(wc * 32 + fr, fq * 8);
#define PG8_SA(b, h) (((b) * 2 + (h)) * HTB)
#define PG8_SB(b, h) ((4 + (b) * 2 + (h)) * HTB)
#define PG8_STAGE(bufoff, gbase, voff) do { _Pragma("unroll") for (int _i = 0; _i < 2; ++_i) \
        __builtin_amdgcn_global_load_lds((const unsigned*)((const char*)(gbase) + (voff)[_i]), (PG8_LAS unsigned*)(lds + (bufoff) + ldsw + _i * 8192), 16, 0, 0); } while (0)
#define PG8_LD2(off_) __builtin_shufflevector(*(const PG8_LAS i32x4*)(lds + (off_)), *(const PG8_LAS i32x4*)(lds + (off_) + 1024), 0, 1, 2, 3, 4, 5, 6, 7)
#define PG8_LDA(dst, b, h) do { _Pragma("unroll") for (int m = 0; m < 4; ++m) dst[m] = PG8_LD2(PG8_SA(b, h) + aoff + m * 2048); } while (0)
#define PG8_LDB(dst, b, h) do { _Pragma("unroll") for (int n = 0; n < 2; ++n) dst[n] = PG8_LD2(PG8_SB(b, h) + boff + n * 2048); } while (0)
#define PG8_HALF(x_, k_) __builtin_bit_cast(bf16x8, __builtin_shufflevector((x_), (x_), 4 * (k_), 4 * (k_) + 1, 4 * (k_) + 2, 4 * (k_) + 3))
#define PG8_HALFI(x_, k_) __builtin_shufflevector((x_), (x_), 4 * (k_), 4 * (k_) + 1, 4 * (k_) + 2, 4 * (k_) + 3)
#define PG8_MMA(ai, bj, At, Bt) do { __builtin_amdgcn_s_setprio(1); \
        if constexpr (Epi::I8) { _Pragma("unroll") for (int m = 0; m < 4; ++m) _Pragma("unroll") for (int n = 0; n < 2; ++n) { \
            i32x4 c_ = __builtin_bit_cast(i32x4, acc[ai][bj][m][n]); \
            c_ = __builtin_amdgcn_mfma_i32_16x16x64_i8(PG8_HALFI(Bt[n], 0), PG8_HALFI(At[m], 0), c_, 0, 0, 0); \
            c_ = __builtin_amdgcn_mfma_i32_16x16x64_i8(PG8_HALFI(Bt[n], 1), PG8_HALFI(At[m], 1), c_, 0, 0, 0); \
            acc[ai][bj][m][n] = __builtin_bit_cast(f32x4, c_); } } \
        else { _Pragma("unroll") for (int m = 0; m < 4; ++m) _Pragma("unroll") for (int n = 0; n < 2; ++n) { \
            acc[ai][bj][m][n] = __builtin_amdgcn_mfma_f32_16x16x32_bf16(PG8_HALF(Bt[n], 0), PG8_HALF(At[m], 0), acc[ai][bj][m][n], 0, 0, 0); \
            acc[ai][bj][m][n] = __builtin_amdgcn_mfma_f32_16x16x32_bf16(PG8_HALF(Bt[n], 1), PG8_HALF(At[m], 1), acc[ai][bj][m][n], 0, 0, 0); } } \
        __builtin_amdgcn_s_setprio(0); } while (0)
#define PG8_WAIT_V(n) asm volatile("s_waitcnt vmcnt(" #n ")" ::: "memory")
#define PG8_WAIT_L(n) asm volatile("s_waitcnt lgkmcnt(" #n ")" ::: "memory")
#define PG8_BAR __builtin_amdgcn_s_barrier()
#define PG8_SCHED __builtin_amdgcn_sched_barrier(0)
    Unit cur, nxt; int ui = 0;
    if (!S.next(0, cur)) return;
    f32x4 acc[2][2][4][2];
#pragma unroll
    for (int a = 0; a < 2; ++a)
#pragma unroll
        for (int b = 0; b < 2; ++b)
#pragma unroll
            for (int m = 0; m < 4; ++m)
#pragma unroll
                for (int n = 0; n < 2; ++n) acc[a][b][m][n] = (f32x4){0.f, 0.f, 0.f, 0.f};
    i32x8 At[4], B0[2], B1[2];
    const char* cA = PG8_PANEL_A(cur); const char* cB = (const char*)(g.Bt + (size_t)cur.grp * g.b_gs) + (size_t)cur.pn * 2 * hsB;
    PG8_STAGE(PG8_SB(0, 0), cB, voffB); PG8_STAGE(PG8_SB(0, 1), cB + hsB, voffB); PG8_STAGE(PG8_SA(0, 0), cA, voffA); PG8_STAGE(PG8_SA(0, 1), cA + hsA, voffA);
    if (wr == 1) PG8_BAR;
    PG8_WAIT_V(2); PG8_BAR;
    PG8_STAGE(PG8_SB(1, 0), cB + kstep, voffB); PG8_STAGE(PG8_SA(1, 0), cA + kstepA, voffA); PG8_STAGE(PG8_SB(1, 1), cB + hsB + kstep, voffB); PG8_STAGE(PG8_SA(1, 1), cA + kstepA + hsA, voffA);
    PG8_WAIT_V(0); PG8_BAR;
    for (;;) {
        const bool has_next = S.next(ui + 1, nxt);
        const char* nA = has_next ? PG8_PANEL_A(nxt) : cA; const char* nB = has_next ? (const char*)(g.Bt + (size_t)nxt.grp * g.b_gs) + (size_t)nxt.pn * 2 * hsB : cB;
#define PG8_WAIT_V0 do { if (t == 0) PG8_WAIT_V(24); else PG8_WAIT_V(8); } while (0)
#pragma clang loop unroll(disable)
        for (int t = 0; t < nt; t += 2) {
            const bool last = (t == nt - 2);
            const char* a1 = cA + (size_t)(t + 1) * kstepA;
            const char* a2 = last ? nA : cA + (size_t)(t + 2) * kstepA; const char* b2 = last ? nB : cB + (size_t)(t + 2) * kstep;
            const char* a3 = a2 + kstepA; const char* b3 = b2 + kstep;
            PG8_LDB(B0, 0, 0); PG8_LDB(B1, 0, 1); PG8_SCHED; PG8_LDA(At, 0, 0); if (t != 0) PG8_STAGE(PG8_SA(1, 1), a1 + hsA, voffA);
            PG8_WAIT_V0; PG8_WAIT_L(0); PG8_BAR; PG8_MMA(0, 0, At, B0); PG8_MMA(0, 1, At, B1); PG8_BAR; PG8_SCHED;
            PG8_LDA(At, 0, 1); PG8_STAGE(PG8_SB(0, 0), b2, voffB); PG8_STAGE(PG8_SB(0, 1), b2 + hsB, voffB); PG8_STAGE(PG8_SA(0, 0), a2, voffA);
            PG8_WAIT_V0; PG8_WAIT_L(0); PG8_BAR; PG8_MMA(1, 0, At, B0); PG8_MMA(1, 1, At, B1); PG8_BAR; PG8_SCHED;
            PG8_LDB(B0, 1, 0); PG8_LDB(B1, 1, 1); PG8_SCHED; PG8_LDA(At, 1, 0); PG8_STAGE(PG8_SA(0, 1), a2 + hsA, voffA);
            PG8_WAIT_V0; PG8_WAIT_L(0); PG8_BAR; PG8_MMA(0, 0, At, B0); PG8_MMA(0, 1, At, B1); PG8_BAR; PG8_SCHED;
            PG8_LDA(At, 1, 1); PG8_STAGE(PG8_SB(1, 0), b3, voffB); PG8_STAGE(PG8_SB(1, 1), b3 + hsB, voffB); PG8_STAGE(PG8_SA(1, 0), a3, voffA);
            PG8_WAIT_V(8); PG8_WAIT_L(0); PG8_BAR; PG8_MMA(1, 0, At, B0); PG8_MMA(1, 1, At, B1); PG8_BAR; PG8_SCHED;
        }
        PG8_STAGE(PG8_SA(1, 1), nA + kstepA + hsA, voffA);
        if (wr == 0) PG8_BAR;
        E(acc, cur, wr, wc, fr, fq);
        if (!has_next) break;
#pragma unroll
        for (int a = 0; a < 2; ++a)
#pragma unroll
            for (int b = 0; b < 2; ++b)
#pragma unroll
                for (int m = 0; m < 4; ++m)
#pragma unroll
                    for (int n = 0; n < 2; ++n) acc[a][b][m][n] = (f32x4){0.f, 0.f, 0.f, 0.f};
        cur = nxt; cA = nA; cB = nB; ++ui;
        if (wr == 1) PG8_BAR;
    }
    PG8_WAIT_V(0);
    PG8_BAR;
#undef PG8_PANEL_A
#undef PG8_SA
#undef PG8_SB
#undef PG8_STAGE
#undef PG8_LDA
#undef PG8_LDB
#undef PG8_MMA
#undef PG8_LD2
#undef PG8_HALF
#undef PG8_HALFI
#undef PG8_WAIT_V
#undef PG8_WAIT_V0
#undef PG8_WAIT_L
#undef PG8_BAR
#undef PG8_SCHED
}
}

#define XB_TMO      128
#define XB_XCNT(j)  (256  + 64 * (j))
#define XB_XSUB(j)  (1280 + 64 * (j))
#define XB_XGEN(j)  (2304 + 64 * (j))
#define XB_TOP      3328
#define XB_TOPGEN   3392
#define XCD_BAR_WORDS 3456
#define XB_SPIN_CAP (1u << 18)
__device__ __forceinline__ unsigned xb_ld(unsigned* p)              { return __hip_atomic_load(p, __ATOMIC_RELAXED, __HIP_MEMORY_SCOPE_AGENT); }
__device__ __forceinline__ unsigned xb_add(unsigned* p, unsigned v) { return __hip_atomic_fetch_add(p, v, __ATOMIC_RELAXED, __HIP_MEMORY_SCOPE_AGENT); }
__device__ __forceinline__ unsigned xb_xcc_id() { return (unsigned)__builtin_amdgcn_s_getreg((3 << 11) | 20) & 0xFu; }
#define XB_SPIN(cond, bar) do { unsigned _sp = 0; while (cond) { __builtin_amdgcn_s_sleep(1); \
    if ((++_sp & 255u) == 0u) { if (xb_ld(&(bar)[XB_TMO])) break; if (_sp > XB_SPIN_CAP) { atomicAdd(&(bar)[XB_TMO], 1u); break; } } } } while (0)
struct XcdBarrier { unsigned* bar; unsigned x; volatile LAS unsigned* st; };
__device__ __forceinline__ XcdBarrier xcd_barrier_post(unsigned* bar, volatile LAS unsigned* st) {
    XcdBarrier b; b.bar = bar; b.x = xb_xcc_id(); b.st = st;
    if (threadIdx.x == 0) (void)xb_add(&bar[XB_XCNT(b.x)], 1u);
    return b;
}
__device__ __forceinline__ void xcd_barrier_complete(unsigned* bar, unsigned x, unsigned& nloc, unsigned& nx) {
    const unsigned G = gridDim.x * gridDim.y * gridDim.z;
    unsigned sum, cnt, mine, sp = 0u;
    for (;;) {
        sum = 0u; cnt = 0u; mine = 0u;
#pragma unroll
        for (unsigned j = 0; j < 16; ++j) { const unsigned c = xb_ld(&bar[XB_XCNT(j)]); sum += c; cnt += (c > 0u) ? 1u : 0u; mine = (j == x) ? c : mine; }
        if (sum == G) break;
        __builtin_amdgcn_s_sleep(1);
        if ((++sp & 255u) == 0u) { if (xb_ld(&bar[XB_TMO])) break; if (sp > XB_SPIN_CAP) { atomicAdd(&bar[XB_TMO], 1u); break; } }
    }
    nloc = mine > 0u ? mine : 1u; nx = cnt > 0u ? cnt : 1u;
}
__device__ __forceinline__ void xcd_barrier(const XcdBarrier& b) {
    asm volatile("s_waitcnt vmcnt(0)" ::: "memory");
    __syncthreads();
    if (threadIdx.x == 0) {
        unsigned* bar = b.bar;
        __builtin_amdgcn_s_waitcnt(0);
        unsigned nloc = b.st[0], nx = b.st[1];
        if (nloc == 0u) { xcd_barrier_complete(bar, b.x, nloc, nx); b.st[0] = nloc; b.st[1] = nx; }
        const unsigned old = xb_add(&bar[XB_XSUB(b.x)], 1u);
        const unsigned gen = old / nloc;
        if (old + 1u == (gen + 1u) * nloc) {
            __builtin_amdgcn_fence(__ATOMIC_RELEASE, "agent");
            asm volatile("s_waitcnt vmcnt(0)" ::: "memory");
            const unsigned og = xb_add(&bar[XB_TOP], 1u);
            const unsigned tg = og / nx;
            if (og + 1u == (tg + 1u) * nx) xb_add(&bar[XB_TOPGEN], 1u);
            else XB_SPIN(xb_ld(&bar[XB_TOPGEN]) == tg, bar);
            __builtin_amdgcn_fence(__ATOMIC_ACQUIRE, "agent");
            xb_add(&bar[XB_XGEN(b.x)], 1u);
            asm volatile("s_waitcnt vmcnt(0)" ::: "memory");
        } else {
            XB_SPIN(xb_ld(&bar[XB_XGEN(b.x)]) == gen, bar);
            __builtin_amdgcn_fence(__ATOMIC_ACQUIRE, "agent");
            asm volatile("s_waitcnt vmcnt(0)" ::: "memory");
        }
    }
    __syncthreads();
}

struct Args {
    const float *x, *c, *ctx, *c_ctx, *norm_w, *w_ada, *b_ada, *w_in, *w_out;
    const float *lam_re, *lam_im, *log_step, *b_re, *b_im, *c_re, *c_im, *s5_d, *w_glu, *b_glu, *pool_w, *pool_scale, *final_norm_w;
    float* out; unsigned char* ws; int ph_lo, ph_hi;
};
struct Ctx {
    LAS unsigned char* lds; int tid, lane, wave, G, wg;
};

__device__ __forceinline__ void p0_transpose_item(const float* W, int K, int N, bf16* WT, LAS float* scr, int item, int lane) {
    const int nblk = N / 32, kb = item / nblk, nb = item % nblk, k0 = 64 * kb, n0 = 32 * nb;
    float ld[32];
#pragma unroll
    for (int i = 0; i < 32; ++i) ld[i] = __builtin_nontemporal_load(W + (size_t)(k0 + 2 * i + (lane >> 5)) * N + n0 + (lane & 31));
#pragma unroll
    for (int i = 0; i < 32; ++i) scr[(2 * i + (lane >> 5)) * 33 + (lane & 31)] = ld[i];
    asm volatile("s_waitcnt lgkmcnt(0)" ::: "memory");
    const int c = lane & 7;
#pragma unroll
    for (int j = 0; j < 4; ++j) { const int n = (lane >> 3) + 8 * j; const LAS float* s = scr + (8 * c) * 33 + n;
        u32x4 o; o.x = cvt_pk_bf16(s[0 * 33], s[1 * 33]); o.y = cvt_pk_bf16(s[2 * 33], s[3 * 33]); o.z = cvt_pk_bf16(s[4 * 33], s[5 * 33]); o.w = cvt_pk_bf16(s[6 * 33], s[7 * 33]);
        __builtin_nontemporal_store(o, (GAS u32x4*)(WT + (size_t)(n0 + n) * K + k0 + 8 * c)); }
    asm volatile("s_waitcnt lgkmcnt(0)" ::: "memory");
}

__device__ __forceinline__ void p0_transpose_item_i8(const float* W, int K, int N, unsigned char* WT, LAS float* scr, int item, int lane, float inv_r) {
    const int nblk = N / 32, pi = item >> 1, kb = 2 * (pi / nblk) + (item & 1), nb = pi % nblk, k0 = 64 * kb, n0 = 32 * nb;
    float ld[32];
#pragma unroll
    for (int i = 0; i < 32; ++i) ld[i] = __builtin_nontemporal_load(W + (size_t)(k0 + 2 * i + (lane >> 5)) * N + n0 + (lane & 31));
#pragma unroll
    for (int i = 0; i < 32; ++i) scr[(2 * i + (lane >> 5)) * 33 + (lane & 31)] = ld[i];
    asm volatile("s_waitcnt lgkmcnt(0)" ::: "memory");
    const int n = lane & 31, hf = lane >> 5; const LAS float* sp = scr + (32 * hf) * 33 + n;
    unsigned w[8];
#pragma unroll
    for (int q = 0; q < 8; ++q) w[q] = pack_i8x4(sp[(4 * q + 0) * 33], sp[(4 * q + 1) * 33], sp[(4 * q + 2) * 33], sp[(4 * q + 3) * 33], inv_r);
    GAS u32x4* dst = (GAS u32x4*)(WT + (size_t)(n0 + n) * K + k0 + 32 * hf);
    dst[0] = (u32x4){w[0], w[1], w[2], w[3]}; dst[1] = (u32x4){w[4], w[5], w[6], w[7]};
    asm volatile("s_waitcnt lgkmcnt(0)" ::: "memory");
}

template <int SET>
__device__ __forceinline__ void p0_convert(const Args& a, const Ctx& F, int gw, int NGW, float r_in, float r_glu) {
    unsigned char* ws = a.ws;
    LAS float* scr = (LAS float*)(F.lds + F.wave * 16384);
    constexpr int I_IN = (DM / 64) * (2 * EI / 32), I_GLU = (EI / 64) * (EI / 32), I_OUT = (EI / 64) * (DM / 32), I_POOL = (2048 / 64) * (2048 / 32);
    if (SET == 0) {
        for (int r = gw; r < I_IN; r += NGW) { if (Q8_L0) p0_transpose_item_i8(a.w_in, DM, 2 * EI, ws + WS_WIN0, scr, r, F.lane, 1.0f / r_in); else p0_transpose_item(a.w_in, DM, 2 * EI, (bf16*)(ws + WS_WIN0), scr, r, F.lane); }
    } else {
        constexpr int NITEMS = I_GLU + 2 * I_OUT + I_IN + 4 * I_POOL;
        for (int it = gw; it < NITEMS; it += NGW) {
            int r = it;
            if (r < I_GLU) { p0_transpose_item_i8(a.w_glu, EI, EI, ws + WS_WGLU, scr, r, F.lane, 1.0f / r_glu); continue; } r -= I_GLU;
            if (r < I_OUT) { p0_transpose_item(a.w_out, EI, DM, (bf16*)(ws + WS_WOUT0), scr, r, F.lane); continue; } r -= I_OUT;
            if (r < I_IN) { if (Q8_L1) p0_transpose_item_i8(a.w_in + (size_t)DM * 2 * EI, DM, 2 * EI, ws + WS_WIN1, scr, r, F.lane, 1.0f / r_in); else p0_transpose_item(a.w_in + (size_t)DM * 2 * EI, DM, 2 * EI, (bf16*)(ws + WS_WIN1), scr, r, F.lane); continue; } r -= I_IN;
            if (r < 4 * I_POOL) { const int k = r / I_POOL; p0_transpose_item(a.pool_w + (size_t)k * 2048 * 2048, 2048, 2048, (bf16*)(ws + WS_WPOOL) + (size_t)k * 2048 * 2048, scr, r % I_POOL, F.lane); continue; } r -= 4 * I_POOL;
            p0_transpose_item(a.w_out + (size_t)EI * DM, EI, DM, (bf16*)(ws + WS_WOUT1), scr, r, F.lane);
        }
    }
}
__device__ __forceinline__ void p0_prologue(const Args& a, const Ctx& F) {
    unsigned char* ws = a.ws;
    {
        LAS float* sc = (LAS float*)F.lds;
        LAS float* red = (LAS float*)(F.lds + 49152);
        for (int i = F.tid; i < 3 * DM; i += NWAVES * 64) { const int r = i / DM, k = i % DM; const float v = (r < 2) ? a.c[r * DM + k] : a.c_ctx[k]; sc[i] = silu_f(v); }
        __syncthreads();
        float* modp = (float*)(ws + WS_MODP);
        for (int u = F.wg; u < 768; u += F.G) {
            const int layer = u / 384, r = u % 384, kh = r / 192, cb = r % 192;
            const int kbeg = kh * 2048 + F.wave * 256;
            const float* W = a.w_ada + (size_t)layer * DM * 12288 + (size_t)kbeg * 12288 + cb * 64 + F.lane;
            float a0 = 0.f, a1 = 0.f, a2 = 0.f;
#pragma unroll 16
            for (int k = 0; k < 256; ++k) { const float w = __builtin_nontemporal_load(W + (size_t)k * 12288); a0 += sc[kbeg + k] * w; a1 += sc[DM + kbeg + k] * w; a2 += sc[2 * DM + kbeg + k] * w; }
            red[(F.wave * 3 + 0) * 64 + F.lane] = a0; red[(F.wave * 3 + 1) * 64 + F.lane] = a1; red[(F.wave * 3 + 2) * 64 + F.lane] = a2;
            __syncthreads();
            if (F.tid < 192) { const int rr = F.tid / 64, cc = F.tid % 64; float s = 0.f;
#pragma unroll
                for (int w = 0; w < 8; ++w) s += red[(w * 3 + rr) * 64 + cc];
                modp[((size_t)(layer * 2 + kh) * 3 + rr) * 12288 + cb * 64 + cc] = s; }
            __syncthreads();
        }
    }
    const int gw = F.wg * NWAVES + F.wave, NGW = F.G * NWAVES;
    float r_in, r_glu;
    {
        LAS float* rq = (LAS float*)(F.lds + 56000);
        float s0 = 0.f, s1 = 0.f;
#pragma unroll 4
        for (int i = 0; i < 32; ++i) { const float x0 = a.w_in[F.tid + 512 * i], x1 = a.w_glu[F.tid + 512 * i]; s0 += x0 * x0; s1 += x1 * x1; }
        s0 = wave_sum(s0); s1 = wave_sum(s1);
        if (F.lane == 0) { rq[F.wave] = s0; rq[8 + F.wave] = s1; }
        __syncthreads();
        float t0 = 0.f, t1 = 0.f;
#pragma unroll
        for (int w = 0; w < 8; ++w) { t0 += rq[w]; t1 += rq[8 + w]; }
        r_in = WIN8_KSIG * sqrtf(t0 * (1.0f / 16384.0f)); r_glu = WG8_KSIG * sqrtf(t1 * (1.0f / 16384.0f));
        if (F.wg == 0 && F.tid == 0) { ((float*)(ws + WS_QR))[0] = r_in; ((float*)(ws + WS_QR))[1] = r_glu; }
    }
    __syncthreads();
    for (int it = F.wave * F.G + F.wg; it < 2 * NG; it += NGW) {
        LAS f32x2* bbs = (LAS f32x2*)(F.lds + F.wave * 16384); LAS f32x2* lms = bbs + 64 * 16;
        {
            const int p = F.lane;
            const float lre = a.lam_re[it * NP + p], lim = a.lam_im[it * NP + p], dt = __expf(a.log_step[it]);
            const float ar = lre * dt, th = lim * dt;
            const float em1 = expm1f(ar), er = em1 + 1.0f; float sn, cs; sincosf(th, &sn, &cs);
            const float sh = sinf(0.5f * th);
            const float lbr = er * cs, lbi = er * sn;
            const float nr = em1 * cs - 2.0f * sh * sh, ni = lbi;
            const float d2 = lre * lre + lim * lim;
            const float c0r = (nr * lre + ni * lim) / d2, c0i = (ni * lre - nr * lim) / d2;
            ((float2*)(ws + WS_S5L))[it * NP + p] = make_float2(lbr * lbr - lbi * lbi, 2.0f * lbr * lbi);
            lms[p] = (f32x2){lbr, lbi};
            const float* bre = a.b_re + ((size_t)it * NP + p) * NJ; const float* bim = a.b_im + ((size_t)it * NP + p) * NJ;
            float br[16], bi[16], lr_[16], li_[16];
#pragma unroll
            for (int j = 0; j < 16; ++j) { const float x = bre[j], y = bim[j]; br[j] = c0r * x - c0i * y; bi[j] = c0r * y + c0i * x; bbs[p * 16 + j] = (f32x2){br[j], bi[j]};
                lr_[j] = lbr * br[j] - lbi * bi[j]; li_[j] = lbr * bi[j] + lbi * br[j]; }
            bf16* Bf = (bf16*)(ws + WS_S5B) + (size_t)it * 2 * 4 * 64 * 8;
#pragma unroll
            for (int sx = 0; sx < 2; ++sx)
#pragma unroll
                for (int h = 0; h < 2; ++h) {
                    u32x4 wr_, wi_;
                    if (sx == 0) { wr_.x = cvt_pk_bf16(lr_[8 * h + 0], lr_[8 * h + 1]); wr_.y = cvt_pk_bf16(lr_[8 * h + 2], lr_[8 * h + 3]); wr_.z = cvt_pk_bf16(lr_[8 * h + 4], lr_[8 * h + 5]); wr_.w = cvt_pk_bf16(lr_[8 * h + 6], lr_[8 * h + 7]);
                                   wi_.x = cvt_pk_bf16(li_[8 * h + 0], li_[8 * h + 1]); wi_.y = cvt_pk_bf16(li_[8 * h + 2], li_[8 * h + 3]); wi_.z = cvt_pk_bf16(li_[8 * h + 4], li_[8 * h + 5]); wi_.w = cvt_pk_bf16(li_[8 * h + 6], li_[8 * h + 7]); }
                    else         { wr_.x = cvt_pk_bf16(br[8 * h + 0], br[8 * h + 1]); wr_.y = cvt_pk_bf16(br[8 * h + 2], br[8 * h + 3]); wr_.z = cvt_pk_bf16(br[8 * h + 4], br[8 * h + 5]); wr_.w = cvt_pk_bf16(br[8 * h + 6], br[8 * h + 7]);
                                   wi_.x = cvt_pk_bf16(bi[8 * h + 0], bi[8 * h + 1]); wi_.y = cvt_pk_bf16(bi[8 * h + 2], bi[8 * h + 3]); wi_.z = cvt_pk_bf16(bi[8 * h + 4], bi[8 * h + 5]); wi_.w = cvt_pk_bf16(bi[8 * h + 6], bi[8 * h + 7]); }
                    const int blk = 2 * (p >> 5), ln = (p & 31) + 32 * sx;
                    *(u32x4*)(Bf + ((size_t)(h * 4 + blk + 0) * 64 + ln) * 8) = wr_;
                    *(u32x4*)(Bf + ((size_t)(h * 4 + blk + 1) * 64 + ln) * 8) = wi_;
                }
        }
        asm volatile("s_waitcnt lgkmcnt(0)" ::: "memory");
        {
            const int j = F.lane & 15, kq = F.lane >> 4;
            const float* cre = a.c_re + ((size_t)it * NJ + j) * NP; const float* cim = a.c_im + ((size_t)it * NJ + j) * NP;
            bf16* Cf = (bf16*)(ws + WS_S5C) + (size_t)it * 2 * 4 * 64 * 8;
#pragma unroll
            for (int ks = 0; ks < 4; ++ks) { const int p0 = 16 * ks + 4 * kq;
                const f32x4 r4 = *(const f32x4*)(cre + p0), i4 = *(const f32x4*)(cim + p0);
                float o1[8], o2[8];
#pragma unroll
                for (int t = 0; t < 4; ++t) { const f32x2 l = lms[p0 + t]; const float ar_ = r4[t] * l.x - i4[t] * l.y, ai_ = r4[t] * l.y + i4[t] * l.x;
                    const float br_ = ar_ * l.x - ai_ * l.y, bi_ = ar_ * l.y + ai_ * l.x;
                    o1[2 * t] = ar_; o1[2 * t + 1] = -ai_; o2[2 * t] = br_; o2[2 * t + 1] = -bi_; }
                u32x4 w1, w2; w1.x = cvt_pk_bf16(o1[0], o1[1]); w1.y = cvt_pk_bf16(o1[2], o1[3]); w1.z = cvt_pk_bf16(o1[4], o1[5]); w1.w = cvt_pk_bf16(o1[6], o1[7]);
                w2.x = cvt_pk_bf16(o2[0], o2[1]); w2.y = cvt_pk_bf16(o2[2], o2[3]); w2.z = cvt_pk_bf16(o2[4], o2[5]); w2.w = cvt_pk_bf16(o2[6], o2[7]);
                *(u32x4*)(Cf + ((size_t)(0 * 4 + ks) * 64 + F.lane) * 8) = w1; *(u32x4*)(Cf + ((size_t)(1 * 4 + ks) * 64 + F.lane) * 8) = w2; }
            const int jb = 8 * (kq & 1);
            float k0[8], k1[8];
#pragma unroll
            for (int e = 0; e < 8; ++e) { k0[e] = 0.f; k1[e] = 0.f; }
            for (int p = 0; p < NP; ++p) { const float cr = cre[p], ci = cim[p]; const f32x2 l = lms[p]; const float lr2 = cr * l.x - ci * l.y, li2 = cr * l.y + ci * l.x;
#pragma unroll
                for (int e = 0; e < 8; ++e) { const f32x2 b = bbs[p * 16 + jb + e]; k0[e] += cr * b.x - ci * b.y; k1[e] += lr2 * b.x - li2 * b.y; } }
            const bool s0 = (kq >> 1) == 0;
            u32x4 w0, w1;
            w0.x = s0 ? cvt_pk_bf16(k0[0], k0[1]) : 0u; w0.y = s0 ? cvt_pk_bf16(k0[2], k0[3]) : 0u; w0.z = s0 ? cvt_pk_bf16(k0[4], k0[5]) : 0u; w0.w = s0 ? cvt_pk_bf16(k0[6], k0[7]) : 0u;
            w1.x = s0 ? cvt_pk_bf16(k1[0], k1[1]) : cvt_pk_bf16(k0[0], k0[1]); w1.y = s0 ? cvt_pk_bf16(k1[2], k1[3]) : cvt_pk_bf16(k0[2], k0[3]);
            w1.z = s0 ? cvt_pk_bf16(k1[4], k1[5]) : cvt_pk_bf16(k0[4], k0[5]); w1.w = s0 ? cvt_pk_bf16(k1[6], k1[7]) : cvt_pk_bf16(k0[6], k0[7]);
            bf16* Kf = (bf16*)(ws + WS_S5K) + (size_t)it * 2 * 64 * 8;
            *(u32x4*)(Kf + ((size_t)0 * 64 + F.lane) * 8) = w0; *(u32x4*)(Kf + ((size_t)1 * 64 + F.lane) * 8) = w1;
        }
        asm volatile("s_waitcnt lgkmcnt(0)" ::: "memory");
    }
    __syncthreads();
    p0_convert<0>(a, F, gw, NGW, r_in, r_glu);
}

__device__ __forceinline__ float wave_max(float v) {
#pragma unroll
    for (int o = 1; o < 64; o <<= 1) v = __builtin_fmaxf(v, __shfl_xor(v, o));
    return v;
}
template <int NSETS, bool Q8>
__device__ __forceinline__ void norm_mod_phase(const Args& a, const Ctx& F, int layer, const float* xsrc, int nrows) {
    LAS float* T = (LAS float*)F.lds;
    const float* modp = (const float*)(a.ws + WS_MODP) + (size_t)layer * 2 * 3 * 12288;
    const float* bada = a.b_ada + (size_t)layer * 12288; const float* nw = a.norm_w + (size_t)layer * DM;
    for (int i = F.tid; i < NSETS * DM; i += NWAVES * 64) { const int s = i / DM, k = i % DM;
        const float shift = bada[k] + modp[s * 12288 + k] + modp[(3 + s) * 12288 + k];
        const float scale = bada[DM + k] + modp[s * 12288 + DM + k] + modp[(3 + s) * 12288 + DM + k];
        T[(s * 2 + 0) * DM + k] = nw[k] * (1.0f + scale); T[(s * 2 + 1) * DM + k] = shift; }
    __syncthreads();
    bf16* XN = (bf16*)(a.ws + WS_XN);
    const int gw = F.wg * NWAVES + F.wave, NGW = F.G * NWAVES;
    for (int m = gw; m < nrows; m += NGW) {
        const int set = m < SEQ ? 0 : (m < M ? 1 : 2);
        const float* src = m < M ? xsrc + (size_t)m * DM : a.ctx + (size_t)(m - M) * DM;
        const GAS f32x4* xr = (const GAS f32x4*)src + F.lane;
        f32x4 v[16]; float s = 0.f;
#pragma unroll
        for (int j = 0; j < 16; ++j) { v[j] = xr[64 * j]; s += (v[j].x * v[j].x + v[j].y * v[j].y) + (v[j].z * v[j].z + v[j].w * v[j].w); }
        const float rstd = 1.0f / sqrtf(wave_sum(s) * (1.0f / DM) + RMS_EPS);
        const LAS f32x4* TA = (const LAS f32x4*)(T + (set * 2 + 0) * DM) + F.lane; const LAS f32x4* TS = (const LAS f32x4*)(T + (set * 2 + 1) * DM) + F.lane;
        if (Q8) {
            float mx = 0.f;
#pragma unroll
            for (int j = 0; j < 16; ++j) { const f32x4 A = TA[64 * j], S = TS[64 * j]; v[j] = v[j] * rstd * A + S;
                mx = __builtin_fmaxf(__builtin_fmaxf(mx, __builtin_fmaxf(__builtin_fabsf(v[j].x), __builtin_fabsf(v[j].y))), __builtin_fmaxf(__builtin_fabsf(v[j].z), __builtin_fabsf(v[j].w))); }
            mx = __builtin_fmaxf(wave_max(mx), 1e-20f); const float inv = 1.0f / mx;
            if (F.lane == 0) ((float*)(a.ws + WS_RS))[(size_t)m * 32] = mx * (1.0f / Q8v);
            GAS unsigned* o4 = (GAS unsigned*)((unsigned char*)XN + (size_t)m * DM) + F.lane;
#pragma unroll
            for (int j = 0; j < 16; ++j) o4[64 * j] = pack_i8x4(v[j].x, v[j].y, v[j].z, v[j].w, inv);
        } else {
            GAS u32x2* o8 = (GAS u32x2*)(XN + (size_t)m * DM) + F.lane;
#pragma unroll
            for (int j = 0; j < 16; ++j) { const f32x4 A = TA[64 * j], S = TS[64 * j]; const f32x4 y = v[j] * rstd * A + S;
                u32x2 w; w.x = cvt_pk_bf16(y.x, y.y); w.y = cvt_pk_bf16(y.z, y.w); o8[64 * j] = w; }
        }
    }
}
template <bool Q8>
__device__ __forceinline__ void norm_mod_phase_b16(const Args& a, const Ctx& F, int layer, const bf16* xsrc) {
    LAS float* T = (LAS float*)F.lds;
    const float* modp = (const float*)(a.ws + WS_MODP) + (size_t)layer * 2 * 3 * 12288;
    const float* bada = a.b_ada + (size_t)layer * 12288; const float* nw = a.norm_w + (size_t)layer * DM;
    for (int i = F.tid; i < 2 * DM; i += NWAVES * 64) { const int s = i / DM, k = i % DM;
        const float shift = bada[k] + modp[s * 12288 + k] + modp[(3 + s) * 12288 + k];
        const float scale = bada[DM + k] + modp[s * 12288 + DM + k] + modp[(3 + s) * 12288 + DM + k];
        T[(s * 2 + 0) * DM + k] = nw[k] * (1.0f + scale); T[(s * 2 + 1) * DM + k] = shift; }
    __syncthreads();
    bf16* XN = (bf16*)(a.ws + WS_XN);
    const int gw = F.wg * NWAVES + F.wave, NGW = F.G * NWAVES;
    for (int m = gw; m < M; m += NGW) {
        const int set = m < SEQ ? 0 : 1;
        const GAS u32x4* xr = (const GAS u32x4*)(xsrc + (size_t)m * DM) + F.lane;
        u32x4 v[8]; float s = 0.f;
#pragma unroll
        for (int j = 0; j < 8; ++j) { v[j] = xr[64 * j];
            const float a0 = bf_lo(v[j].x), a1 = bf_hi(v[j].x), a2 = bf_lo(v[j].y), a3 = bf_hi(v[j].y), a4 = bf_lo(v[j].z), a5 = bf_hi(v[j].z), a6 = bf_lo(v[j].w), a7 = bf_hi(v[j].w);
            s += ((a0 * a0 + a1 * a1) + (a2 * a2 + a3 * a3)) + ((a4 * a4 + a5 * a5) + (a6 * a6 + a7 * a7)); }
        const float rstd = 1.0f / sqrtf(wave_sum(s) * (1.0f / DM) + RMS_EPS);
        const LAS f32x4* TA = (const LAS f32x4*)(T + (set * 2 + 0) * DM) + 2 * F.lane; const LAS f32x4* TS = (const LAS f32x4*)(T + (set * 2 + 1) * DM) + 2 * F.lane;
        if (Q8) {
            f32x4 y[16]; float mx = 0.f;
#pragma unroll
            for (int j = 0; j < 8; ++j) { const f32x4 A0 = TA[128 * j], A1 = TA[128 * j + 1], S0 = TS[128 * j], S1 = TS[128 * j + 1];
                const f32x4 x0 = (f32x4){bf_lo(v[j].x), bf_hi(v[j].x), bf_lo(v[j].y), bf_hi(v[j].y)}, x1 = (f32x4){bf_lo(v[j].z), bf_hi(v[j].z), bf_lo(v[j].w), bf_hi(v[j].w)};
                y[2 * j] = x0 * rstd * A0 + S0; y[2 * j + 1] = x1 * rstd * A1 + S1;
#pragma unroll
                for (int t = 0; t < 2; ++t) mx = __builtin_fmaxf(__builtin_fmaxf(mx, __builtin_fmaxf(__builtin_fabsf(y[2 * j + t].x), __builtin_fabsf(y[2 * j + t].y))), __builtin_fmaxf(__builtin_fabsf(y[2 * j + t].z), __builtin_fabsf(y[2 * j + t].w))); }
            mx = __builtin_fmaxf(wave_max(mx), 1e-20f); const float inv = 1.0f / mx;
            if (F.lane == 0) ((float*)(a.ws + WS_RS))[(size_t)m * 32] = mx * (1.0f / Q8v);
            GAS u32x2* o8 = (GAS u32x2*)((unsigned char*)XN + (size_t)m * DM) + F.lane;
#pragma unroll
            for (int j = 0; j < 8; ++j) { u32x2 w; w.x = pack_i8x4(y[2 * j].x, y[2 * j].y, y[2 * j].z, y[2 * j].w, inv); w.y = pack_i8x4(y[2 * j + 1].x, y[2 * j + 1].y, y[2 * j + 1].z, y[2 * j + 1].w, inv); o8[64 * j] = w; }
        } else {
            GAS u32x4* o16 = (GAS u32x4*)(XN + (size_t)m * DM) + F.lane;
#pragma unroll
            for (int j = 0; j < 8; ++j) { const f32x4 A0 = TA[128 * j], A1 = TA[128 * j + 1], S0 = TS[128 * j], S1 = TS[128 * j + 1];
                const f32x4 x0 = (f32x4){bf_lo(v[j].x), bf_hi(v[j].x), bf_lo(v[j].y), bf_hi(v[j].y)}, x1 = (f32x4){bf_lo(v[j].z), bf_hi(v[j].z), bf_lo(v[j].w), bf_hi(v[j].w)};
                const f32x4 y0 = x0 * rstd * A0 + S0, y1 = x1 * rstd * A1 + S1;
                u32x4 w; w.x = cvt_pk_bf16(y0.x, y0.y); w.y = cvt_pk_bf16(y0.z, y0.w); w.z = cvt_pk_bf16(y1.x, y1.y); w.w = cvt_pk_bf16(y1.z, y1.w); o16[64 * j] = w; }
        }
    }
}
__device__ __forceinline__ void final_norm_phase(const Args& a, const Ctx& F) {
    const bf16* X2 = (const bf16*)(a.ws + WS_X2);
    const int gw = F.wg * NWAVES + F.wave, NGW = F.G * NWAVES;
    for (int m = gw; m < M; m += NGW) {
        const GAS u32x4* xr = (const GAS u32x4*)(X2 + (size_t)m * DM) + F.lane; const GAS f32x4* wv = (const GAS f32x4*)a.final_norm_w + 2 * F.lane;
        GAS f32x4* orow = (GAS f32x4*)(a.out + (size_t)m * DM) + 2 * F.lane;
        u32x4 v[8]; float s = 0.f;
#pragma unroll
        for (int j = 0; j < 8; ++j) { v[j] = xr[64 * j];
            const float a0 = bf_lo(v[j].x), a1 = bf_hi(v[j].x), a2 = bf_lo(v[j].y), a3 = bf_hi(v[j].y), a4 = bf_lo(v[j].z), a5 = bf_hi(v[j].z), a6 = bf_lo(v[j].w), a7 = bf_hi(v[j].w);
            s += ((a0 * a0 + a1 * a1) + (a2 * a2 + a3 * a3)) + ((a4 * a4 + a5 * a5) + (a6 * a6 + a7 * a7)); }
        const float rstd = 1.0f / sqrtf(wave_sum(s) * (1.0f / DM) + RMS_EPS);
#pragma unroll
        for (int j = 0; j < 8; ++j) {
            const f32x4 x0 = (f32x4){bf_lo(v[j].x), bf_hi(v[j].x), bf_lo(v[j].y), bf_hi(v[j].y)}, x1 = (f32x4){bf_lo(v[j].z), bf_hi(v[j].z), bf_lo(v[j].w), bf_hi(v[j].w)};
            orow[128 * j] = x0 * rstd * wv[128 * j]; orow[128 * j + 1] = x1 * rstd * wv[128 * j + 1]; }
    }
}

__device__ __forceinline__ f32x2 gelu2(f32x2 v) {
    const f32x2 t = v * v, w = t * (-0.10294324f) + (-2.3022082f), a = v * w;
    f32x2 e; e.x = __builtin_amdgcn_exp2f(a.x); e.y = __builtin_amdgcn_exp2f(a.y);
    const f32x2 q = e + 1.0f; f32x2 r; r.x = __builtin_amdgcn_rcpf(q.x); r.y = __builtin_amdgcn_rcpf(q.y);
    return v * r;
}
template <bool REV>
__device__ __forceinline__ void s5_latent(const bf16* U, bf16* YA, unsigned char* Y8, size_t gbase, const bf16x8 (&Bf)[2][4], const bf16x8 (&Cf)[2][4], const bf16x8 (&Kf)[2],
                                          float lr, float li, float hre, float him, LAS unsigned char* my, f32x4 dsk, int lane) {
    constexpr int SG = REV ? -1 : 1;
    constexpr int TSTEP = SG * 64 * 16, CSTEP16 = SG * 32 * 16, SSTEP = SG * 16;
    const float nli = -li;
    const int nl = lane & 31, hl = lane >> 5, tk = lane & 15, kq = lane >> 4;
    const bf16* pA = U + gbase + SG * (2 * nl + hl) * 16;
    const bf16* pB = U + gbase + SG * (2 * tk + (kq >> 1)) * 16 + 8 * (kq & 1);
    const bf16* pU = U + gbase + SG * (2 * tk) * 16 + 4 * kq;
    bf16* pY = YA + gbase + SG * (2 * tk) * 16 + 4 * kq;
    bf16x8 A0 = *(const bf16x8*)pA, A1 = *(const bf16x8*)(pA + 8);
    bf16x8 Ub[2]; Ub[0] = *(const bf16x8*)pB; Ub[1] = *(const bf16x8*)(pB + CSTEP16);
    u32x2 pv[2][2], uv[2][2];
#pragma unroll
    for (int th = 0; th < 2; ++th)
#pragma unroll
        for (int sx = 0; sx < 2; ++sx) { pv[th][sx] = (u32x2){0u, 0u}; uv[th][sx] = (u32x2){0u, 0u}; }
    const f32x2 dsk01 = (f32x2){dsk[0], dsk[1]}, dsk23 = (f32x2){dsk[2], dsk[3]};
    LAS unsigned* wbase = (LAS unsigned*)(my + ((lane & 3) << 2));
    for (int tile = 0; tile < 128; ++tile) {
        const bool second = tile >= 64;
        if (tile == 64) {
            asm volatile("s_waitcnt vmcnt(0)" ::: "memory"); __syncthreads();
            __builtin_amdgcn_fence(__ATOMIC_ACQUIRE, "agent"); asm volatile("s_waitcnt vmcnt(0)" ::: "memory");
#pragma unroll
            for (int th = 0; th < 2; ++th)
#pragma unroll
                for (int sx = 0; sx < 2; ++sx) { pv[th][sx] = *(const u32x2*)(pY + th * CSTEP16 + sx * SSTEP); uv[th][sx] = *(const u32x2*)(pU + th * CSTEP16 + sx * SSTEP); }
        }
        const int adv = (tile + 1 < 128) ? TSTEP : 0;
        f32x16 acc[4];
#pragma unroll
        for (int i = 0; i < 4; ++i) { acc[i] = (f32x16){0.f,0.f,0.f,0.f,0.f,0.f,0.f,0.f,0.f,0.f,0.f,0.f,0.f,0.f,0.f,0.f};
            acc[i] = __builtin_amdgcn_mfma_f32_32x32x16_bf16(A0, Bf[0][i], acc[i], 0, 0, 0); acc[i] = __builtin_amdgcn_mfma_f32_32x32x16_bf16(A1, Bf[1][i], acc[i], 0, 0, 0); }
        A0 = *(const bf16x8*)(pA + adv); A1 = *(const bf16x8*)(pA + adv + 8);
        float sre0[16], sre1[16], sim0[16], sim1[16];
#pragma unroll
        for (int r = 0; r < 16; ++r) {
            auto s0 = __builtin_amdgcn_permlane32_swap(__float_as_uint(acc[0][r]), __float_as_uint(acc[2][r]), false, false);
            auto s1 = __builtin_amdgcn_permlane32_swap(__float_as_uint(acc[1][r]), __float_as_uint(acc[3][r]), false, false);
            sre0[r] = __uint_as_float(s0[0]); sre1[r] = __uint_as_float(s0[1]); sim0[r] = __uint_as_float(s1[0]); sim1[r] = __uint_as_float(s1[1]); }
#pragma unroll
        for (int i2 = 0; i2 < 16; ++i2) {
            unsigned hw[2];
#pragma unroll
            for (int e = 0; e < 2; ++e) { const int i = 2 * i2 + e;
                const int r = (i & 3) + 4 * (i >> 3); const bool up = (i >> 2) & 1;
                const float sr = up ? sre1[r] : sre0[r], si = up ? sim1[r] : sim0[r];
                hw[e] = cvt_pk_bf16(hre, him);
                const float nre = __builtin_fmaf(lr, hre, __builtin_fmaf(nli, him, sr)), nim = __builtin_fmaf(lr, him, __builtin_fmaf(li, hre, si)); hre = nre; him = nim; }
            LAS unsigned* wp = wbase + (2 * i2) * 64 + ((((lane >> 2) ^ (i2 & 15)) << 2));
            wp[0] = hw[0]; wp[64] = hw[1];
        }
#pragma unroll
        for (int th = 0; th < 2; ++th) {
            bf16x8 Hf[4];
#pragma unroll
            for (int ks = 0; ks < 4; ++ks) Hf[ks] = *(const LAS bf16x8*)(my + (16 * th + tk) * 256 + ((((4 * ks + kq) ^ ((8 * th + (tk >> 1)) & 15))) << 4));
#pragma unroll
            for (int sx = 0; sx < 2; ++sx) {
                f32x4 y = (f32x4){0.f, 0.f, 0.f, 0.f};
                y = __builtin_amdgcn_mfma_f32_16x16x32_bf16(Kf[sx], Ub[th], y, 0, 0, 0);
#pragma unroll
                for (int ks = 0; ks < 4; ++ks) y = __builtin_amdgcn_mfma_f32_16x16x32_bf16(Cf[sx][ks], Hf[ks], y, 0, 0, 0);
                bf16* yo = pY + th * CSTEP16 + sx * SSTEP;
                if (!second) { u32x2 w; w.x = cvt_pk_bf16_mfma(y[0], y[1]); w.y = cvt_pk_bf16(y[2], y[3]); *(u32x2*)yo = w; }
                else { const u32x2 p = pv[th][sx], u = uv[th][sx];
                    const f32x2 v01 = (f32x2){y[0], y[1]} + (f32x2){bf_lo(p.x), bf_hi(p.x)} + dsk01 * (f32x2){bf_lo(u.x), bf_hi(u.x)};
                    const f32x2 v23 = (f32x2){y[2], y[3]} + (f32x2){bf_lo(p.y), bf_hi(p.y)} + dsk23 * (f32x2){bf_lo(u.y), bf_hi(u.y)};
                    const f32x2 o01 = gelu2(v01), o23 = gelu2(v23);
                    u32x2 w; w.x = cvt_pk_bf16(o01.x, o01.y); w.y = cvt_pk_bf16(o23.x, o23.y); *(u32x2*)yo = w;
                    { const unsigned x8 = pack_i8x4(o01.x, o01.y, o23.x, o23.y, 1.0f / YA8_R);
                      *(unsigned*)(Y8 + (yo - YA)) = x8; }
                    pv[th][sx] = *(const u32x2*)(yo + adv); uv[th][sx] = *(const u32x2*)(pU + th * CSTEP16 + sx * SSTEP + adv); }
            }
            Ub[th] = *(const bf16x8*)(pB + th * CSTEP16 + adv);
        }
        pA += adv; pB += adv; pU += adv; pY += adv;
    }
}
__device__ __forceinline__ void s5_phase(const Args& a, const Ctx& F) {
    unsigned char* ws = a.ws;
    const int b = F.wg >> 7, gq = F.wg & 127, d = F.wave >> 2, g = gq * 4 + (F.wave & 3), dg = d * NG + g, lane = F.lane;
    const bf16* U = (const bf16*)(ws + WS_U); bf16* YA = (bf16*)(ws + WS_YA); const float* UCP = (const float*)(ws + WS_UCP);
    bf16x8 Bf[2][4], Cf[2][4], Kf[2];
#pragma unroll
    for (int sx = 0; sx < 2; ++sx) {
#pragma unroll
        for (int i = 0; i < 4; ++i) { Bf[sx][i] = *(const bf16x8*)((const bf16*)(ws + WS_S5B) + ((size_t)((dg * 2 + sx) * 4 + i) * 64 + lane) * 8); Cf[sx][i] = *(const bf16x8*)((const bf16*)(ws + WS_S5C) + ((size_t)((dg * 2 + sx) * 4 + i) * 64 + lane) * 8); }
        Kf[sx] = *(const bf16x8*)((const bf16*)(ws + WS_S5K) + ((size_t)(dg * 2 + sx) * 64 + lane) * 8); }
    const float2 lam2 = ((const float2*)(ws + WS_S5L))[dg * NP + lane];
    const float lr = lam2.x, li = lam2.y, nli = -lam2.y;
    float hre = 0.f, him = 0.f;
    const int nl = lane & 31, hl = lane >> 5, tk = lane & 15, kq = lane >> 4;
    LAS unsigned char* my = F.lds + F.wave * 8192;
    const f32x4 dsk = *(const f32x4*)(a.s5_d + 16 * g + 4 * kq);
    const int chan0 = 16 * g;
    const size_t lat0 = (size_t)b * SEQ;
    const int sgn = d ? -1 : 1;
#define S5_STATE_IN(A0_, A1_) \
        f32x16 acc[4]; \
        _Pragma("unroll") for (int i = 0; i < 4; ++i) { acc[i] = (f32x16){0.f,0.f,0.f,0.f,0.f,0.f,0.f,0.f,0.f,0.f,0.f,0.f,0.f,0.f,0.f,0.f}; \
            acc[i] = __builtin_amdgcn_mfma_f32_32x32x16_bf16(A0_, Bf[0][i], acc[i], 0, 0, 0); acc[i] = __builtin_amdgcn_mfma_f32_32x32x16_bf16(A1_, Bf[1][i], acc[i], 0, 0, 0); } \
        float sre0[16], sre1[16], sim0[16], sim1[16]; \
        _Pragma("unroll") for (int r = 0; r < 16; ++r) { \
            auto s0 = __builtin_amdgcn_permlane32_swap(__float_as_uint(acc[0][r]), __float_as_uint(acc[2][r]), false, false); \
            auto s1 = __builtin_amdgcn_permlane32_swap(__float_as_uint(acc[1][r]), __float_as_uint(acc[3][r]), false, false); \
            sre0[r] = __uint_as_float(s0[0]); sre1[r] = __uint_as_float(s0[1]); sim0[r] = __uint_as_float(s1[0]); sim1[r] = __uint_as_float(s1[1]); }
    for (int tile = 0; tile < 4; ++tile) {
        bf16x8 A01[2];
#pragma unroll
        for (int sx = 0; sx < 2; ++sx) {
            const int q = tile * 64 + 2 * nl + hl, t = d ? (CTXL - 1 - q) : q;
            const float* p0 = UCP + (size_t)(b * CTXL + t) * EI + chan0 + 8 * sx;
            f32x4 lo = *(const f32x4*)p0, hi = *(const f32x4*)(p0 + 4);
#pragma unroll
            for (int k = 1; k < 4; ++k) { lo += *(const f32x4*)(p0 + (size_t)k * MC * EI); hi += *(const f32x4*)(p0 + (size_t)k * MC * EI + 4); }
            u32x4 w; w.x = cvt_pk_bf16(lo[0], lo[1]); w.y = cvt_pk_bf16(lo[2], lo[3]); w.z = cvt_pk_bf16(hi[0], hi[1]); w.w = cvt_pk_bf16(hi[2], hi[3]);
            A01[sx] = __builtin_bit_cast(bf16x8, w);
        }
        S5_STATE_IN(A01[0], A01[1])
#pragma unroll
        for (int i = 0; i < 32; ++i) {
            const int r = (i & 3) + 4 * (i >> 3); const bool up = (i >> 2) & 1;
            const float sr = up ? sre1[r] : sre0[r], si = up ? sim1[r] : sim0[r];
            const float nre = __builtin_fmaf(lr, hre, __builtin_fmaf(nli, him, sr)), nim = __builtin_fmaf(lr, him, __builtin_fmaf(li, hre, si)); hre = nre; him = nim;
        }
    }
    const size_t gbase = ((size_t)(b * NG + g) * SEQ + (d ? SEQ - 1 : 0)) * 16;
    unsigned char* Y8 = ws + WS_YA8;
    if (d) s5_latent<true>(U, YA, Y8, gbase, Bf, Cf, Kf, lr, li, hre, him, my, dsk, lane);
    else s5_latent<false>(U, YA, Y8, gbase, Bf, Cf, Kf, lr, li, hre, him, my, dsk, lane);
#undef S5_STATE_IN
}

template <int W>
__device__ __forceinline__ void pool_item(const Ctx& F, const bf16* Ub, bf16* Db, int r0, int nr) {
    constexpr int HW = W / 2, NS = W + 2;
    LAS f32x2* buf = (LAS f32x2*)F.lds;
    for (int i = F.tid; i < 2048; i += NWAVES * 64) { const int bi = i >> 10, rem = i & 1023, cp = rem >> 6, ln = rem & 63; buf[(bi * 80 + (cp < 8 ? cp : cp + 64)) * 64 + ln] = (f32x2){0.f, 0.f}; }
    const int c0 = 8 * F.wave, lane = F.lane;
    f32x2 Vv[8];
#pragma unroll
    for (int j = 0; j < 8; ++j) Vv[j] = (f32x2){0.f, 0.f};
    float icc[8];
#pragma unroll
    for (int j = 0; j < 8; ++j) { const int c = c0 + j, clo = c - HW > 0 ? c - HW : 0, chi = c + HW < 64 ? c + HW : 64; icc[j] = 1.0f / (float)(chi - clo); }
    unsigned ring[NS][8];
    const int rs = r0 - W + 1, re = r0 + nr;
#define POOL_LOAD(slot_, r_) do { int e_ = (r_) + HW - 1; e_ = e_ < 0 ? 0 : (e_ > 127 ? 127 : e_); \
        _Pragma("unroll") for (int j = 0; j < 8; ++j) ring[slot_][j] = *(const GAS unsigned*)(Ub + ((size_t)e_ * 64 + c0 + j) * EI); } while (0)
    POOL_LOAD(0, rs); POOL_LOAD(1, rs + 1);
    __syncthreads();
    for (int base = rs; base < re; base += NS) {
#pragma unroll
        for (int u = 0; u < NS; ++u) {
            const int r = base + u;
            if (r < re) {
                POOL_LOAD((u + 2) % NS, r + 2);
                const int e = r + HW - 1;
                const float me = (e >= 0 && e < 128) ? 1.0f : 0.0f, ml = (r >= r0 && r - HW >= 0) ? 1.0f : 0.0f;
#pragma unroll
                for (int j = 0; j < 8; ++j) { Vv[j].x += me * bf_lo(ring[u][j]); Vv[j].y += me * bf_hi(ring[u][j]); }
                if (r >= r0) {
                    LAS f32x2* row = buf + ((r & 1) * 80 + 8) * 64 + lane;
#pragma unroll
                    for (int j = 0; j < 8; ++j) row[(c0 + j) * 64] = Vv[j];
                    asm volatile("s_waitcnt lgkmcnt(0)" ::: "memory"); __builtin_amdgcn_s_barrier(); asm volatile("" ::: "memory");
                    const int rlo = r - HW > 0 ? r - HW : 0, rhi = r + HW < 128 ? r + HW : 128; const float icr = 1.0f / (float)(rhi - rlo);
                    f32x2 h = (f32x2){0.f, 0.f};
#pragma unroll
                    for (int c = -HW; c < HW; ++c) h += row[(c0 + c) * 64];
#pragma unroll
                    for (int j = 0; j < 8; ++j) {
                        const float ic = icr * icc[j]; const unsigned m = ring[(u + NS - HW + 1) % NS][j];
                        *(GAS unsigned*)(Db + ((size_t)r * 64 + c0 + j) * EI) = cvt_pk_bf16(h.x * ic - bf_lo(m), h.y * ic - bf_hi(m));
                        h += row[(c0 + j + HW) * 64] - row[(c0 + j - HW) * 64];
                    }
#pragma unroll
                    for (int j = 0; j < 8; ++j) { const unsigned l = ring[(u + NS - W + 1) % NS][j]; Vv[j].x -= ml * bf_lo(l); Vv[j].y -= ml * bf_hi(l); }
                }
            }
        }
    }
#undef POOL_LOAD
    __syncthreads();
}
__device__ __forceinline__ void pool_phase(const Args& a, const Ctx& F) {
    const bf16* U = (const bf16*)(a.ws + WS_U); bf16* D = (bf16*)(a.ws + WS_YA);
    for (int it = F.wg; it < 256; it += F.G) {
        const int b = it >> 7, cb = (it >> 1) & 63, seg = it & 1, k = cb >> 4;
        const size_t base = (size_t)b * SEQ * EI + (size_t)cb * 128 + 2 * F.lane;
        if (k == 0) pool_item<2>(F, U + base, D + base, seg * 64, 64);
        else if (k == 1) pool_item<4>(F, U + base, D + base, seg * 64, 64);
        else if (k == 2) pool_item<8>(F, U + base, D + base, seg * 64, 64);
        else pool_item<16>(F, U + base, D + base, seg * 64, 64);
    }
}

__global__ void __launch_bounds__(NWAVES * 64, 2) trunk_fwd(Args a) {
    extern __shared__ __attribute__((aligned(16))) unsigned char lds_raw[];
    Ctx F; F.lds = (LAS unsigned char*)lds_raw; F.tid = threadIdx.x; F.lane = F.tid & 63; F.wave = __builtin_amdgcn_readfirstlane(F.tid >> 6);
    F.G = gridDim.x; F.wg = blockIdx.x;
    volatile LAS unsigned* MISC = (volatile LAS unsigned*)(F.lds + MISC_OFF);
    if (F.tid < 64) MISC[F.tid] = 0u;
    __syncthreads();
    unsigned* ctl = (unsigned*)(a.ws + WS_CTL);
    XcdBarrier bar; bar.bar = ctl + CW_BAR; bar.x = 0; bar.st = nullptr;
    if (MK_N_LAUNCHES == 1) bar = xcd_barrier_post(ctl + CW_BAR, MISC + 8);
    const int lo = a.ph_lo, hi = a.ph_hi;
#ifndef PHASE_MASK
#define PHASE_MASK 0xFFF
#endif
#define IN(k) (((PHASE_MASK >> (k)) & 1) && lo <= (k) && (k) < hi)
#define SEAM(k) do { if (IN(k) && IN((k) + 1)) { XcdBarrier b_; b_.bar = (unsigned*)(a.ws + WS_CTL) + CW_BAR; b_.x = xb_xcc_id(); b_.st = (volatile LAS unsigned*)(F.lds + MISC_OFF) + 8; xcd_barrier(b_); } } while (0)
#ifndef PHASE_REPS
#define PHASE_REPS {1,1,1,1,1,1,1,1,1,1,1,1}
#endif
    constexpr int REP[N_PHASES] = PHASE_REPS;
#define REPEAT(k) for (int rep_ = 0; rep_ < REP[k]; ++rep_)
#define REPSYNC(k) do { if (rep_ + 1 < REP[k]) xcd_barrier(bar); } while (0)
    unsigned char* ws = a.ws;
    const float* modp = (const float*)(ws + WS_MODP);

    if (IN(0)) REPEAT(0) { F.lane = lane_id_asm(); F.tid = F.wave * 64 + F.lane; p0_prologue(a, F); REPSYNC(0); } SEAM(0);
    if (IN(1)) REPEAT(1) { F.lane = lane_id_asm(); F.tid = F.wave * 64 + F.lane; norm_mod_phase<3, Q8_L0 != 0>(a, F, 0, a.x, MT); REPSYNC(1); } SEAM(1);
    if (IN(2)) REPEAT(2) { F.lane = lane_id_asm(); F.tid = F.wave * 64 + F.lane;
        constexpr int KD = Q8_L0 ? DM / 2 : DM;
        if (F.wg < NGEMM_P2) {
        pg8::Gemm g{(const bf16*)(ws + WS_XN), (const bf16*)(ws + WS_WIN0), KD, KD, KD, 0, 0, 0}; pg8::StaticOrder S{64, 64, NGEMM_P2, F.wg};
        pg8::EpiInProj<Q8_L0 != 0> E{(bf16*)(ws + WS_U), (bf16*)(ws + WS_SZ), 1, (const float*)(ws + WS_RS), (const float*)(ws + WS_QR)};
        pg8::gemm_phase(F.lds, g, S, E, F.wave);
        pg8::Gemm gc{(const bf16*)(ws + WS_XN), (const bf16*)(ws + WS_WIN0), KD, KD, KD / 4, (size_t)(KD / 4), (size_t)(KD / 4), 0}; pg8::CtxOrder Sc{NGEMM_P2, F.wg};
        pg8::EpiCtx<Q8_L0 != 0> Ec{(float*)(ws + WS_UCP), (const float*)(ws + WS_RS), (const float*)(ws + WS_QR)};
        pg8::gemm_phase(F.lds, gc, Sc, Ec, F.wave);
        } else { const float r_glu = ((const float*)(ws + WS_QR))[1]; p0_convert<1>(a, F, (F.wg - NGEMM_P2) * NWAVES + F.wave, (F.G - NGEMM_P2) * NWAVES, 1.0f, r_glu); }
        REPSYNC(2);
    } SEAM(2);
    if (IN(3)) REPEAT(3) { F.lane = lane_id_asm(); F.tid = F.wave * 64 + F.lane; s5_phase(a, F); REPSYNC(3); } SEAM(3);
    if (IN(4)) REPEAT(4) { F.lane = lane_id_asm(); F.tid = F.wave * 64 + F.lane;
        pg8::Gemm g{(const bf16*)(ws + WS_YA8), (const bf16*)(ws + WS_WGLU), EI / 2, EI / 2, EI / 2, 0, 0, 2}; pg8::StaticOrder S{64, 32, F.G, F.wg};
        pg8::EpiGlu E{(const bf16*)(ws + WS_YA), (const bf16*)(ws + WS_SZ), (bf16*)(ws + WS_U), a.b_glu, (const float*)(ws + WS_QR)};
        pg8::gemm_phase(F.lds, g, S, E, F.wave); REPSYNC(4);
    } SEAM(4);
    if (IN(5)) REPEAT(5) { F.lane = lane_id_asm(); F.tid = F.wave * 64 + F.lane;
        pg8::Gemm g{(const bf16*)(ws + WS_U), (const bf16*)(ws + WS_WOUT0), EI, EI, EI, 0, 0, 0}; pg8::StaticOrder S{64, 16, F.G, F.wg};
        pg8::EpiOut<false> E{a.x, (bf16*)(ws + WS_X1), modp, modp + 3 * 12288, a.b_ada + 8192};
        pg8::gemm_phase(F.lds, g, S, E, F.wave); REPSYNC(5);
    } SEAM(5);
    if (IN(6)) REPEAT(6) { F.lane = lane_id_asm(); F.tid = F.wave * 64 + F.lane; norm_mod_phase_b16<Q8_L1 != 0>(a, F, 1, (const bf16*)(ws + WS_X1)); REPSYNC(6); } SEAM(6);
    if (IN(7)) REPEAT(7) { F.lane = lane_id_asm(); F.tid = F.wave * 64 + F.lane;
        constexpr int KD = Q8_L1 ? DM / 2 : DM;
        pg8::Gemm g{(const bf16*)(ws + WS_XN), (const bf16*)(ws + WS_WIN1), KD, KD, KD, 0, 0, 0}; pg8::StaticOrder S{64, 64, F.G, F.wg};
        pg8::EpiInProj<Q8_L1 != 0> E{(bf16*)(ws + WS_U), (bf16*)(ws + WS_SZ), 0, (const float*)(ws + WS_RS), (const float*)(ws + WS_QR)};
        pg8::gemm_phase(F.lds, g, S, E, F.wave); REPSYNC(7);
    } SEAM(7);
    if (IN(8)) REPEAT(8) { F.lane = lane_id_asm(); F.tid = F.wave * 64 + F.lane; pool_phase(a, F); REPSYNC(8); } SEAM(8);
    if (IN(9)) REPEAT(9) { F.lane = lane_id_asm(); F.tid = F.wave * 64 + F.lane;
        pg8::Gemm g{(const bf16*)(ws + WS_YA), (const bf16*)(ws + WS_WPOOL), EI, 2048, 2048, 2048, (size_t)2048 * 2048, 0}; pg8::PoolOrder S{F.G, F.wg};
        pg8::EpiPool E{(const bf16*)(ws + WS_SZ), (bf16*)(ws + WS_U), a.pool_scale};
        pg8::gemm_phase(F.lds, g, S, E, F.wave); REPSYNC(9);
    } SEAM(9);
    if (IN(10)) REPEAT(10) { F.lane = lane_id_asm(); F.tid = F.wave * 64 + F.lane;
        pg8::Gemm g{(const bf16*)(ws + WS_U), (const bf16*)(ws + WS_WOUT1), EI, EI, EI, 0, 0, 0}; pg8::StaticOrder S{64, 16, F.G, F.wg};
        pg8::EpiOut<true> E{(const bf16*)(ws + WS_X1), (bf16*)(ws + WS_X2), modp + 6 * 12288, modp + 9 * 12288, a.b_ada + 12288 + 8192};
        pg8::gemm_phase(F.lds, g, S, E, F.wave); REPSYNC(10);
    } SEAM(10);
    if (IN(11)) REPEAT(11) { F.lane = lane_id_asm(); F.tid = F.wave * 64 + F.lane; final_norm_phase(a, F); }
#undef IN
#undef SEAM
}

extern "C" void kernel_launch(void* const* d_in, const int* in_sizes, int n_in, void* d_out, int out_size, void* d_ws, size_t ws_size, hipStream_t stream) {
    static int grid = 0;
    if (grid == 0) {
        if (n_in != 22 || in_sizes[0] != M * DM || out_size != M * DM || ws_size < WS_END) { fprintf(stderr, "kernel_launch: unexpected shapes (n_in %d, in0 %d, out %d, ws %zu); nothing launched\n", n_in, n_in > 0 ? in_sizes[0] : -1, out_size, ws_size); grid = -1; return; }
        int dev = 0, cus = 0, per_cu = 0;
        if (hipGetDevice(&dev) != hipSuccess || hipDeviceGetAttribute(&cus, hipDeviceAttributeMultiprocessorCount, dev) != hipSuccess) { grid = -1; return; }
        if (hipFuncSetAttribute((const void*)trunk_fwd, hipFuncAttributeMaxDynamicSharedMemorySize, LDS_BYTES) != hipSuccess) { fprintf(stderr, "kernel_launch: hipFuncSetAttribute failed\n"); grid = -1; return; }
        if (hipOccupancyMaxActiveBlocksPerMultiprocessor(&per_cu, (const void*)trunk_fwd, NWAVES * 64, LDS_BYTES) != hipSuccess || per_cu < 1) { fprintf(stderr, "kernel_launch: occupancy query reports %d workgroups per CU\n", per_cu); }
        (void)hipGetLastError();
        grid = cus;
        if (grid != 256) { fprintf(stderr, "kernel_launch: built for 256 CUs, device has %d\n", cus); grid = -1; return; }
    }
    if (grid < 0) return;
    (void)hipMemsetAsync((char*)d_ws + WS_CTL, 0, CTL_ZERO_BYTES, stream);
    Args a{};
    const float* const* in = (const float* const*)d_in;
    a.x = in[0]; a.c = in[1]; a.ctx = in[2]; a.c_ctx = in[3]; a.norm_w = in[4]; a.w_ada = in[5]; a.b_ada = in[6]; a.w_in = in[7]; a.w_out = in[8];
    a.lam_re = in[9]; a.lam_im = in[10]; a.log_step = in[11]; a.b_re = in[12]; a.b_im = in[13]; a.c_re = in[14]; a.c_im = in[15]; a.s5_d = in[16];
    a.w_glu = in[17]; a.b_glu = in[18]; a.pool_w = in[19]; a.pool_scale = in[20]; a.final_norm_w = in[21];
    a.out = (float*)d_out; a.ws = (unsigned char*)d_ws;
    if (MK_N_LAUNCHES == 1) { a.ph_lo = 0; a.ph_hi = N_PHASES; hipLaunchKernelGGL(trunk_fwd, dim3(grid), dim3(NWAVES * 64), LDS_BYTES, stream, a); }
    else for (int p = 0; p < N_PHASES; ++p) { a.ph_lo = p; a.ph_hi = p + 1; hipLaunchKernelGGL(trunk_fwd, dim3(grid), dim3(NWAVES * 64), LDS_BYTES, stream, a); }
}
```

```cpp
#include <hip/hip_runtime.h>
#include <cstdio>
#include <cstdint>

#ifndef MK_N_LAUNCHES
#define MK_N_LAUNCHES 1
#endif
constexpr int N_PHASES = 12;

constexpr int DM = 4096, NB = 2, SEQ = 8192, CTXL = 256, EI = 8192, NG = 512, NP = 64, NJ = 16;
constexpr int M = NB * SEQ;
constexpr int MC = NB * CTXL;
constexpr int MT = M + MC;
constexpr float RMS_EPS = 1e-6f;
constexpr int NWAVES = 8;
constexpr int NGEMM_P2 = 216;

constexpr size_t MiB = 1u << 20;
constexpr size_t WS_CTL = 0, CTL_ZERO_BYTES = 64 * 1024;
constexpr size_t WS_MODP = 1 * MiB;
constexpr size_t WS_S5B = 2 * MiB;
constexpr size_t WS_S5C = 10 * MiB;
constexpr size_t WS_S5K = 18 * MiB;
constexpr size_t WS_S5L = 20 * MiB;
constexpr size_t WS_WIN0 = 24 * MiB, WS_WIN1 = 152 * MiB, WS_WGLU = 280 * MiB, WS_WOUT0 = 408 * MiB, WS_WOUT1 = 472 * MiB, WS_WPOOL = 536 * MiB;
constexpr size_t WS_XN = 568 * MiB;
constexpr size_t WS_U = 700 * MiB;
constexpr size_t WS_SZ = 964 * MiB;
constexpr size_t WS_YA = 1220 * MiB;
constexpr size_t WS_X1 = 1476 * MiB;
constexpr size_t WS_X2 = 1604 * MiB;
constexpr size_t WS_UCP = 1732 * MiB;
constexpr size_t WS_YA8 = 1796 * MiB;
constexpr size_t WS_RS = 21 * MiB;
constexpr size_t WS_END = 1924 * MiB;
constexpr int CW_BAR = 4096;

constexpr int RING_BYTES = 131072;
constexpr int MISC_OFF = RING_BYTES;
constexpr int LDS_BYTES = 147456;

#define GAS __attribute__((address_space(1)))
#define LAS __attribute__((address_space(3)))
typedef unsigned short bf16;
typedef short bf16x8 __attribute__((ext_vector_type(8)));
typedef float f32x4 __attribute__((ext_vector_type(4)));
typedef float f32x16 __attribute__((ext_vector_type(16)));
typedef float f32x2 __attribute__((ext_vector_type(2)));
typedef unsigned u32x4 __attribute__((ext_vector_type(4)));
typedef unsigned u32x2 __attribute__((ext_vector_type(2)));
typedef int i32x4 __attribute__((ext_vector_type(4)));
typedef int i32x8 __attribute__((ext_vector_type(8)));
typedef short s16x2 __attribute__((ext_vector_type(2)));
#ifndef Q8_L0
#define Q8_L0 1
#endif
#ifndef Q8_L1
#define Q8_L1 0
#endif
constexpr float WIN8_KSIG = 4.8f, WG8_KSIG = 5.25f;
constexpr size_t WS_QR = 23 * MiB + 512 * 1024;
constexpr float YA8_R = 14.0f, Q8 = 32767.0f / 256.0f, Q8v = Q8;
__device__ __forceinline__ unsigned pack_i8x4(float x0, float x1, float x2, float x3, float inv_r) {
    s16x2 p = __builtin_amdgcn_cvt_pknorm_i16(x0 * inv_r, x1 * inv_r), q = __builtin_amdgcn_cvt_pknorm_i16(x2 * inv_r, x3 * inv_r); const s16x2 r = {128, 128};
    p = __builtin_elementwise_add_sat(p, r); q = __builtin_elementwise_add_sat(q, r);
    return __builtin_amdgcn_perm(__builtin_bit_cast(unsigned, q), __builtin_bit_cast(unsigned, p), 0x07050301u); }

__device__ __forceinline__ unsigned cvt_pk_bf16(float lo, float hi) { unsigned r; asm volatile("v_cvt_pk_bf16_f32 %0, %1, %2" : "=v"(r) : "v"(lo), "v"(hi)); return r; }
__device__ __forceinline__ unsigned cvt_pk_bf16_mfma(float lo, float hi) { unsigned r; asm volatile("s_nop 7\n\ts_nop 4\n\tv_cvt_pk_bf16_f32 %0, %1, %2" : "=v"(r) : "v"(lo), "v"(hi)); return r; }
__device__ __forceinline__ float bf_lo(unsigned w) { return __uint_as_float(w << 16); }
__device__ __forceinline__ float bf_hi(unsigned w) { return __uint_as_float(w & 0xffff0000u); }
__device__ __forceinline__ float fast_sigmoid(float x) { return __builtin_amdgcn_rcpf(1.0f + __builtin_amdgcn_exp2f(-1.4426950408889634f * x)); }
__device__ __forceinline__ float silu_f(float x) { return x * fast_sigmoid(x); }
__device__ __forceinline__ float gelu_tanh(float x) { const float z = x * (1.5957691216057308f + 0.07135481627260025f * x * x); return x * fast_sigmoid(z); }
__device__ __forceinline__ int lane_id_asm() { int l; asm volatile("v_mbcnt_lo_u32_b32 %0, -1, 0\n\tv_mbcnt_hi_u32_b32 %0, -1, %0" : "=v"(l)); return l; }
__device__ __forceinline__ float wave_sum(float v) {
#pragma unroll
    for (int o = 1; o < 64; o <<= 1) v += __shfl_xor(v, o);
    return v;
}

namespace pg8 {
#define PG8_LAS __attribute__((address_space(3)))
constexpr int BM = 256, BK = 64, HALF = 128, HTB = HALF * BK * 2, STAGE_BYTES = 8 * HTB, NXCD = 8, WGM = 8;
__host__ __device__ __forceinline__ int lds_byte(int r, int c) { const int st = (r >> 4) * 2 + (c >> 5), rr = r & 15, cc = c & 31, ob = rr * 64 + cc * 2; return st * 1024 + (ob ^ (((ob >> 9) & 1) << 5)); }
__host__ __device__ __forceinline__ void stage_rc(int b, int& R, int& C) { const int st = b / 1024, sb = b % 1024, swz = sb ^ (((sb >> 9) & 1) << 5); R = (st >> 1) * 16 + swz / 64; C = (st & 1) * 32 + (swz % 64) / 2; }
__host__ __device__ __forceinline__ int perm32(int rho) { const int n = rho >> 4, i = rho & 15; return 8 * (i >> 2) + 4 * n + (i & 3); }

struct Unit { int pm, pn, grp; };
struct Gemm { const bf16* A; const bf16* Bt; int lda, ldb, K; size_t a_gs, b_gs; int a_gm; };

__device__ __forceinline__ void static_unit(int L, int nM, int nN, int& pm, int& pn) {
    if (nN >= 16) {
        const int blk = L >> 8, within = L & 255, xs = within & 7, off = within >> 3, nJ = nN >> 4;
        const int I = blk / nJ, jj = blk - I * nJ, J = (I & 1) ? nJ - 1 - jj : jj;
        pm = 16 * I + 8 * (xs & 1) + (off & 7); pn = 16 * J + 4 * (xs >> 1) + (off >> 3);
        return;
    }
    if (nN == 8) {
        const int blk = L >> 8, within = L & 255, xs = within & 7, off = within >> 3;
        pm = 32 * blk + 8 * (xs & 3) + (off & 7); pn = 4 * (xs >> 2) + (off >> 3);
        return;
    }
    const int nwg = nM * nN; int wgid = L;
    { const int q = nwg / NXCD, r = nwg % NXCD, xcd = wgid % NXCD, off = wgid / NXCD; wgid = (xcd < r ? xcd * (q + 1) : r * (q + 1) + (xcd - r) * q) + off; }
    const int nig = WGM * nN, gid = wgid / nig, fm = gid * WGM, gsz = (nM - fm) < WGM ? (nM - fm) : WGM;
    pm = fm + ((wgid % nig) % gsz); pn = (wgid % nig) / gsz;
}
struct StaticOrder {
    int nM, nN, G, c;
    __device__ __forceinline__ bool next(int i, Unit& u) const { const int L = i * G + c; if (L >= nM * nN) return false; static_unit(L, nM, nN, u.pm, u.pn); u.grp = 0; return true; }
};
struct CtxOrder {
    int G, c;
    __device__ __forceinline__ bool next(int i, Unit& u) const { const int L = i * G + c; if (L >= 256) return false; const int cu = L >> 2; u.grp = L & 3; u.pm = 64 + (cu >> 5); u.pn = cu & 31; return true; }
};
struct PoolOrder {
    int G, c;
    __device__ __forceinline__ bool next(int i, Unit& u) const { const int L = i * G + c; if (L >= 2048) return false; u.grp = L >> 9; static_unit(L & 511, 64, 8, u.pm, u.pn); return true; }
};

template <bool Q8>
struct EpiInProj {
    static constexpr bool PERM = true, I8 = Q8;
    bf16* U; bf16* SZ; int gm; const float* rowscale; const float* qr;
    __device__ __forceinline__ void operator()(const f32x4 (&acc)[2][2][4][2], const Unit& u, int wr, int wc, int fr, int fq) const {
        const int row0 = u.pm * BM + wr * 64 + fr; const bool isz = u.pn >= 32;
        bf16* base = isz ? SZ : U; const int col0 = (isz ? u.pn - 32 : u.pn) * BM + wc * 32 + 8 * fq;
        const bool g_ = gm && !isz;
#pragma unroll
        for (int ai = 0; ai < 2; ++ai)
#pragma unroll
            for (int m = 0; m < 4; ++m) { const int row = row0 + ai * HALF + m * 16;
                bf16* rowp = g_ ? base + ((size_t)((row >> 13) * NG + (col0 >> 4)) * SEQ + (row & (SEQ - 1))) * 16 + (col0 & 15) : base + (size_t)row * EI + col0;
                const int bjs = g_ ? 8 * SEQ * 16 : HALF;
                float dq = 1.0f; if (Q8) dq = rowscale[(size_t)row * 32] * (qr[0] * (1.0f / ::Q8));
#pragma unroll
                for (int bj = 0; bj < 2; ++bj) { f32x4 v0 = acc[ai][bj][m][0], v1 = acc[ai][bj][m][1];
                    if (Q8) { const i32x4 q0 = __builtin_bit_cast(i32x4, v0), q1 = __builtin_bit_cast(i32x4, v1);
                        v0 = (f32x4){(float)q0[0], (float)q0[1], (float)q0[2], (float)q0[3]} * dq; v1 = (f32x4){(float)q1[0], (float)q1[1], (float)q1[2], (float)q1[3]} * dq; }
                    if (isz) {
#pragma unroll
                        for (int j = 0; j < 4; ++j) { v0[j] = silu_f(v0[j]); v1[j] = silu_f(v1[j]); } }
                    u32x4 w; w.x = cvt_pk_bf16(v0[0], v0[1]); w.y = cvt_pk_bf16(v0[2], v0[3]); w.z = cvt_pk_bf16(v1[0], v1[1]); w.w = cvt_pk_bf16(v1[2], v1[3]);
                    if (isz) __builtin_nontemporal_store(w, (u32x4*)(rowp + (size_t)bj * bjs)); else *(u32x4*)(rowp + (size_t)bj * bjs) = w; }
                asm volatile("" ::: "memory"); }
    }
};
template <bool Q8>
struct EpiCtx {
    static constexpr bool PERM = false, I8 = Q8;
    float* P; const float* rowscale; const float* qr;
    __device__ __forceinline__ void operator()(const f32x4 (&acc)[2][2][4][2], const Unit& u, int wr, int wc, int fr, int fq) const {
        const int row0 = (u.pm - 64) * BM + wr * 64 + fr, col0 = u.pn * BM + wc * 32 + 4 * fq; float* base = P + (size_t)u.grp * MC * EI;
#pragma unroll
        for (int ai = 0; ai < 2; ++ai)
#pragma unroll
            for (int m = 0; m < 4; ++m) { const int row = row0 + ai * HALF + m * 16; float* rowp = base + (size_t)row * EI + col0;
                float dq = 1.0f; if (Q8) dq = rowscale[(size_t)(M + row) * 32] * (qr[0] * (1.0f / ::Q8));
#pragma unroll
                for (int bj = 0; bj < 2; ++bj)
#pragma unroll
                    for (int n = 0; n < 2; ++n) { f32x4 v = acc[ai][bj][m][n];
                        if (Q8) { const i32x4 q = __builtin_bit_cast(i32x4, v); v = (f32x4){(float)q[0], (float)q[1], (float)q[2], (float)q[3]} * dq; }
                        *(f32x4*)(rowp + bj * HALF + n * 16) = v; } }
    }
};
struct EpiGlu {
    static constexpr bool PERM = true, I8 = true;
    const bf16* YA; const bf16* SZ; bf16* V; const float* bias; const float* qr;
    __device__ __forceinline__ void operator()(const f32x4 (&acc)[2][2][4][2], const Unit& u, int wr, int wc, int fr, int fq) const {
        const int row0 = u.pm * BM + wr * 64 + fr, col0 = u.pn * BM + wc * 32 + 8 * fq;
        const float GATE_DEQ = YA8_R * qr[1] * (1.0f / (::Q8 * ::Q8));
        f32x4 bv[2][2];
#pragma unroll
        for (int bj = 0; bj < 2; ++bj)
#pragma unroll
            for (int n = 0; n < 2; ++n) bv[bj][n] = *(const f32x4*)(bias + col0 + bj * HALF + 4 * n);
#pragma unroll
        for (int ai = 0; ai < 2; ++ai)
#pragma unroll
            for (int m = 0; m < 4; ++m) { const int row = row0 + ai * HALF + m * 16; const size_t off = (size_t)row * EI + col0;
                const size_t offy = ((size_t)((row >> 13) * NG + (col0 >> 4)) * SEQ + (row & (SEQ - 1))) * 16 + (col0 & 15);
#pragma unroll
                for (int bj = 0; bj < 2; ++bj) { const u32x4 yv = *(const u32x4*)(YA + offy + (size_t)bj * 8 * SEQ * 16), zv = *(const u32x4*)(SZ + off + bj * HALF);
                    const i32x4 q0 = __builtin_bit_cast(i32x4, acc[ai][bj][m][0]), q1 = __builtin_bit_cast(i32x4, acc[ai][bj][m][1]);
                    const f32x4 g0 = (f32x4){(float)q0[0], (float)q0[1], (float)q0[2], (float)q0[3]} * GATE_DEQ + bv[bj][0], g1 = (f32x4){(float)q1[0], (float)q1[1], (float)q1[2], (float)q1[3]} * GATE_DEQ + bv[bj][1];
                    float o[8];
                    o[0] = bf_lo(yv.x) * bf_lo(zv.x) * fast_sigmoid(g0[0]); o[1] = bf_hi(yv.x) * bf_hi(zv.x) * fast_sigmoid(g0[1]);
                    o[2] = bf_lo(yv.y) * bf_lo(zv.y) * fast_sigmoid(g0[2]); o[3] = bf_hi(yv.y) * bf_hi(zv.y) * fast_sigmoid(g0[3]);
                    o[4] = bf_lo(yv.z) * bf_lo(zv.z) * fast_sigmoid(g1[0]); o[5] = bf_hi(yv.z) * bf_hi(zv.z) * fast_sigmoid(g1[1]);
                    o[6] = bf_lo(yv.w) * bf_lo(zv.w) * fast_sigmoid(g1[2]); o[7] = bf_hi(yv.w) * bf_hi(zv.w) * fast_sigmoid(g1[3]);
                    u32x4 w; w.x = cvt_pk_bf16(o[0], o[1]); w.y = cvt_pk_bf16(o[2], o[3]); w.z = cvt_pk_bf16(o[4], o[5]); w.w = cvt_pk_bf16(o[6], o[7]);
                    *(u32x4*)(V + off + bj * HALF) = w; } }
    }
};
struct EpiPool {
    static constexpr bool PERM = true, I8 = false;
    const bf16* SZ; bf16* V; const float* scale;
    __device__ __forceinline__ void operator()(const f32x4 (&acc)[2][2][4][2], const Unit& u, int wr, int wc, int fr, int fq) const {
        const int row0 = u.pm * BM + wr * 64 + fr, col0 = u.grp * 2048 + u.pn * BM + wc * 32 + 8 * fq;
        f32x4 sv[2][2];
#pragma unroll
        for (int bj = 0; bj < 2; ++bj)
#pragma unroll
            for (int n = 0; n < 2; ++n) sv[bj][n] = *(const f32x4*)(scale + col0 + bj * HALF + 4 * n);
#pragma unroll
        for (int ai = 0; ai < 2; ++ai)
#pragma unroll
            for (int m = 0; m < 4; ++m) { const size_t off = (size_t)(row0 + ai * HALF + m * 16) * EI + col0;
#pragma unroll
                for (int bj = 0; bj < 2; ++bj) { const u32x4 zv = *(const u32x4*)(SZ + off + bj * HALF);
                    const f32x4 g0 = acc[ai][bj][m][0] * sv[bj][0], g1 = acc[ai][bj][m][1] * sv[bj][1];
                    u32x4 w; w.x = cvt_pk_bf16(g0[0] * bf_lo(zv.x), g0[1] * bf_hi(zv.x)); w.y = cvt_pk_bf16(g0[2] * bf_lo(zv.y), g0[3] * bf_hi(zv.y));
                    w.z = cvt_pk_bf16(g1[0] * bf_lo(zv.z), g1[1] * bf_hi(zv.z)); w.w = cvt_pk_bf16(g1[2] * bf_lo(zv.w), g1[3] * bf_hi(zv.w));
                    *(u32x4*)(V + off + bj * HALF) = w; } }
    }
};
template <bool BASE_BF16>
struct EpiOut {
    static constexpr bool PERM = true, I8 = false;
    const void* base; bf16* out; const float* gp0; const float* gp1; const float* gb;
    __device__ __forceinline__ void operator()(const f32x4 (&acc)[2][2][4][2], const Unit& u, int wr, int wc, int fr, int fq) const {
        const int row0 = u.pm * BM + wr * 64 + fr, col0 = u.pn * BM + wc * 32 + 8 * fq; const int b = u.pm >> 5;
        f32x4 gv[2][2];
#pragma unroll
        for (int bj = 0; bj < 2; ++bj)
#pragma unroll
            for (int n = 0; n < 2; ++n) { const int c = col0 + bj * HALF + 4 * n;
                gv[bj][n] = *(const f32x4*)(gp0 + b * 12288 + 8192 + c) + *(const f32x4*)(gp1 + b * 12288 + 8192 + c) + *(const f32x4*)(gb + c); }
#pragma unroll
        for (int ai = 0; ai < 2; ++ai)
#pragma unroll
            for (int m = 0; m < 4; ++m) { const size_t off = (size_t)(row0 + ai * HALF + m * 16) * DM + col0;
#pragma unroll
                for (int bj = 0; bj < 2; ++bj) {
                    f32x4 b0, b1;
                    if (BASE_BF16) { const u32x4 bw = *(const u32x4*)((const bf16*)base + off + bj * HALF); b0 = (f32x4){bf_lo(bw.x), bf_hi(bw.x), bf_lo(bw.y), bf_hi(bw.y)}; b1 = (f32x4){bf_lo(bw.z), bf_hi(bw.z), bf_lo(bw.w), bf_hi(bw.w)}; }
                    else { b0 = *(const f32x4*)((const float*)base + off + bj * HALF); b1 = *(const f32x4*)((const float*)base + off + bj * HALF + 4); }
                    const f32x4 o0 = b0 + gv[bj][0] * acc[ai][bj][m][0], o1 = b1 + gv[bj][1] * acc[ai][bj][m][1];
                    u32x4 w; w.x = cvt_pk_bf16(o0[0], o0[1]); w.y = cvt_pk_bf16(o0[2], o0[3]); w.z = cvt_pk_bf16(o1[0], o1[1]); w.w = cvt_pk_bf16(o1[2], o1[3]);
                    *(u32x4*)(out + off + bj * HALF) = w; }
                if (m & 1) asm volatile("" ::: "memory"); }
    }
};

template <class Epi, class Sched>
__device__ __forceinline__ void gemm_phase(PG8_LAS unsigned char* lds, const Gemm g, const Sched& S, const Epi& E, int wave_) {
    const int wid = wave_, lane = lane_id_asm(), tid = wid * 64 + lane, wr = wid >> 2, wc = wid & 3, fr = lane & 15, fq = lane >> 4;
    const int K = g.K, nt = K / BK;
    unsigned voffA[2], voffB[2];
#pragma unroll
    for (int i = 0; i < 2; ++i) { int R, C; stage_rc(tid * 16 + i * 8192, R, C); const int Rb = Epi::PERM ? ((R & ~31) + perm32(R & 31)) : R;
        voffA[i] = g.a_gm == 2 ? (unsigned)(((C >> 3) * SEQ + R) * 16) : g.a_gm ? (unsigned)(((C >> 4) * SEQ + R) * 32 + (C & 15) * 2) : (unsigned)(R * g.lda + C) * 2u; voffB[i] = (unsigned)(Rb * g.ldb + C) * 2u; }
    const int gmb = g.a_gm == 2 ? 16 : 32;
    const size_t kstep = (size_t)(BK * 2), kstepA = g.a_gm ? (size_t)(128 / gmb) * SEQ * gmb : kstep;
    const size_t hsA = g.a_gm ? (size_t)HALF * gmb : (size_t)HALF * g.lda * 2, hsB = (size_t)HALF * g.ldb * 2;
#define PG8_PANEL_A(u_) (g.a_gm ? (const char*)g.A + ((size_t)((u_).pm >> 5) * NG * SEQ + (size_t)((u_).pm & 31) * BM) * gmb : (const char*)(g.A + (size_t)(u_).grp * g.a_gs) + (size_t)(u_).pm * 2 * hsA)
    const unsigned ldsw = (unsigned)wid * 1024u;
    const int aoff = lds_byte(wr * 64 + fr, fq * 8), boff = lds_byte(wc * 32 + fr, fq * 8);
#define PG8_SA(b, h) (((b) * 2 + (h)) * HTB)
#define PG8_SB(b, h) ((4 + (b) * 2 + (h)) * HTB)
#define PG8_STAGE(bufoff, gbase, voff) do { _Pragma("unroll") for (int _i = 0; _i < 2; ++_i) \
        __builtin_amdgcn_global_load_lds((const unsigned*)((const char*)(gbase) + (voff)[_i]), (PG8_LAS unsigned*)(lds + (bufoff) + ldsw + _i * 8192), 16, 0, 0); } while (0)
#define PG8_LD2(off_) __builtin_shufflevector(*(const PG8_LAS i32x4*)(lds + (off_)), *(const PG8_LAS i32x4*)(lds + (off_) + 1024), 0, 1, 2, 3, 4, 5, 6, 7)
#define PG8_LDA(dst, b, h) do { _Pragma("unroll") for (int m = 0; m < 4; ++m) dst[m] = PG8_LD2(PG8_SA(b, h) + aoff + m * 2048); } while (0)
#define PG8_LDB(dst, b, h) do { _Pragma("unroll") for (int n = 0; n < 2; ++n) dst[n] = PG8_LD2(PG8_SB(b, h) + boff + n * 2048); } while (0)
#define PG8_HALF(x_, k_) __builtin_bit_cast(bf16x8, __builtin_shufflevector((x_), (x_), 4 * (k_), 4 * (k_) + 1, 4 * (k_) + 2, 4 * (k_) + 3))
#define PG8_HALFI(x_, k_) __builtin_shufflevector((x_), (x_), 4 * (k_), 4 * (k_) + 1, 4 * (k_) + 2, 4 * (k_) + 3)
#define PG8_MMA(ai, bj, At, Bt) do { __builtin_amdgcn_s_setprio(1); \
        if constexpr (Epi::I8) { _Pragma("unroll") for (int m = 0; m < 4; ++m) _Pragma("unroll") for (int n = 0; n < 2; ++n) { \
            i32x4 c_ = __builtin_bit_cast(i32x4, acc[ai][bj][m][n]); \
            c_ = __builtin_amdgcn_mfma_i32_16x16x64_i8(PG8_HALFI(Bt[n], 0), PG8_HALFI(At[m], 0), c_, 0, 0, 0); \
            c_ = __builtin_amdgcn_mfma_i32_16x16x64_i8(PG8_HALFI(Bt[n], 1), PG8_HALFI(At[m], 1), c_, 0, 0, 0); \
            acc[ai][bj][m][n] = __builtin_bit_cast(f32x4, c_); } } \
        else { _Pragma("unroll") for (int m = 0; m < 4; ++m) _Pragma("unroll") for (int n = 0; n < 2; ++n) { \
            acc[ai][bj][m][n] = __builtin_amdgcn_mfma_f32_16x16x32_bf16(PG8_HALF(Bt[n], 0), PG8_HALF(At[m], 0), acc[ai][bj][m][n], 0, 0, 0); \
            acc[ai][bj][m][n] = __builtin_amdgcn_mfma_f32_16x16x32_bf16(PG8_HALF(Bt[n], 1), PG8_HALF(At[m], 1), acc[ai][bj][m][n], 0, 0, 0); } } \
        __builtin_amdgcn_s_setprio(0); } while (0)
#define PG8_WAIT_V(n) asm volatile("s_waitcnt vmcnt(" #n ")" ::: "memory")
#define PG8_WAIT_L(n) asm volatile("s_waitcnt lgkmcnt(" #n ")" ::: "memory")
#define PG8_BAR __builtin_amdgcn_s_barrier()
#define PG8_SCHED __builtin_amdgcn_sched_barrier(0)
    Unit cur, nxt; int ui = 0;
    if (!S.next(0, cur)) return;
    f32x4 acc[2][2][4][2];
#pragma unroll
    for (int a = 0; a < 2; ++a)
#pragma unroll
        for (int b = 0; b < 2; ++b)
#pragma unroll
            for (int m = 0; m < 4; ++m)
#pragma unroll
                for (int n = 0; n < 2; ++n) acc[a][b][m][n] = (f32x4){0.f, 0.f, 0.f, 0.f};
    i32x8 At[4], B0[2], B1[2];
    const char* cA = PG8_PANEL_A(cur); const char* cB = (const char*)(g.Bt + (size_t)cur.grp * g.b_gs) + (size_t)cur.pn * 2 * hsB;
    PG8_STAGE(PG8_SB(0, 0), cB, voffB); PG8_STAGE(PG8_SB(0, 1), cB + hsB, voffB); PG8_STAGE(PG8_SA(0, 0), cA, voffA); PG8_STAGE(PG8_SA(0, 1), cA + hsA, voffA);
    if (wr == 1) PG8_BAR;
    PG8_WAIT_V(2); PG8_BAR;
    PG8_STAGE(PG8_SB(1, 0), cB + kstep, voffB); PG8_STAGE(PG8_SA(1, 0), cA + kstepA, voffA); PG8_STAGE(PG8_SB(1, 1), cB + hsB + kstep, voffB); PG8_STAGE(PG8_SA(1, 1), cA + kstepA + hsA, voffA);
    PG8_WAIT_V(0); PG8_BAR;
    for (;;) {
        const bool has_next = S.next(ui + 1, nxt);
        const char* nA = has_next ? PG8_PANEL_A(nxt) : cA; const char* nB = has_next ? (const char*)(g.Bt + (size_t)nxt.grp * g.b_gs) + (size_t)nxt.pn * 2 * hsB : cB;
#define PG8_WAIT_V0 do { if (t == 0) PG8_WAIT_V(24); else PG8_WAIT_V(8); } while (0)
#pragma clang loop unroll(disable)
        for (int t = 0; t < nt; t += 2) {
            const bool last = (t == nt - 2);
            const char* a1 = cA + (size_t)(t + 1) * kstepA;
            const char* a2 = last ? nA : cA + (size_t)(t + 2) * kstepA; const char* b2 = last ? nB : cB + (size_t)(t + 2) * kstep;
            const char* a3 = a2 + kstepA; const char* b3 = b2 + kstep;
            PG8_LDB(B0, 0, 0); PG8_LDB(B1, 0, 1); PG8_SCHED; PG8_LDA(At, 0, 0); if (t != 0) PG8_STAGE(PG8_SA(1, 1), a1 + hsA, voffA);
            PG8_WAIT_V0; PG8_WAIT_L(0); PG8_BAR; PG8_MMA(0, 0, At, B0); PG8_MMA(0, 1, At, B1); PG8_BAR; PG8_SCHED;
            PG8_LDA(At, 0, 1); PG8_STAGE(PG8_SB(0, 0), b2, voffB); PG8_STAGE(PG8_SB(0, 1), b2 + hsB, voffB); PG8_STAGE(PG8_SA(0, 0), a2, voffA);
            PG8_WAIT_V0; PG8_WAIT_L(0); PG8_BAR; PG8_MMA(1, 0, At, B0); PG8_MMA(1, 1, At, B1); PG8_BAR; PG8_SCHED;
            PG8_LDB(B0, 1, 0); PG8_LDB(B1, 1, 1); PG8_SCHED; PG8_LDA(At, 1, 0); PG8_STAGE(PG8_SA(0, 1), a2 + hsA, voffA);
            PG8_WAIT_V0; PG8_WAIT_L(0); PG8_BAR; PG8_MMA(0, 0, At, B0); PG8_MMA(0, 1, At, B1); PG8_BAR; PG8_SCHED;
            PG8_LDA(At, 1, 1); PG8_STAGE(PG8_SB(1, 0), b3, voffB); PG8_STAGE(PG8_SB(1, 1), b3 + hsB, voffB); PG8_STAGE(PG8_SA(1, 0), a3, voffA);
            PG8_WAIT_V(8); PG8_WAIT_L(0); PG8_BAR; PG8_MMA(1, 0, At, B0); PG8_MMA(1, 1, At, B1); PG8_BAR; PG8_SCHED;
        }
        PG8_STAGE(PG8_SA(1, 1), nA + kstepA + hsA, voffA);
        if (wr == 0) PG8_BAR;
        E(acc, cur, wr, wc, fr, fq);
        if (!has_next) break;
#pragma unroll
        for (int a = 0; a < 2; ++a)
#pragma unroll
            for (int b = 0; b < 2; ++b)
#pragma unroll
                for (int m = 0; m < 4; ++m)
#pragma unroll
                    for (int n = 0; n < 2; ++n) acc[a][b][m][n] = (f32x4){0.f, 0.f, 0.f, 0.f};
        cur = nxt; cA = nA; cB = nB; ++ui;
        if (wr == 1) PG8_BAR;
    }
    PG8_WAIT_V(0);
    PG8_BAR;
#undef PG8_PANEL_A
#undef PG8_SA
#undef PG8_SB
#undef PG8_STAGE
#undef PG8_LDA
#undef PG8_LDB
#undef PG8_MMA
#undef PG8_LD2
#undef PG8_HALF
#undef PG8_HALFI
#undef PG8_WAIT_V
#undef PG8_WAIT_V0
#undef PG8_WAIT_L
#undef PG8_BAR
#undef PG8_SCHED
}
}

#define XB_TMO      128
#define XB_XCNT(j)  (256  + 64 * (j))
#define XB_XSUB(j)  (1280 + 64 * (j))
#define XB_XGEN(j)  (2304 + 64 * (j))
#define XB_TOP      3328
#define XB_TOPGEN   3392
#define XCD_BAR_WORDS 3456
#define XB_SPIN_CAP (1u << 18)
__device__ __forceinline__ unsigned xb_ld(unsigned* p)              { return __hip_atomic_load(p, __ATOMIC_RELAXED, __HIP_MEMORY_SCOPE_AGENT); }
__device__ __forceinline__ unsigned xb_add(unsigned* p, unsigned v) { return __hip_atomic_fetch_add(p, v, __ATOMIC_RELAXED, __HIP_MEMORY_SCOPE_AGENT); }
__device__ __forceinline__ unsigned xb_xcc_id() { return (unsigned)__builtin_amdgcn_s_getreg((3 << 11) | 20) & 0xFu; }
#define XB_SPIN(cond, bar) do { unsigned _sp = 0; while (cond) { __builtin_amdgcn_s_sleep(1); \
    if ((++_sp & 255u) == 0u) { if (xb_ld(&(bar)[XB_TMO])) break; if (_sp > XB_SPIN_CAP) { atomicAdd(&(bar)[XB_TMO], 1u); break; } } } } while (0)
struct XcdBarrier { unsigned* bar; unsigned x; volatile LAS unsigned* st; };
__device__ __forceinline__ XcdBarrier xcd_barrier_post(unsigned* bar, volatile LAS unsigned* st) {
    XcdBarrier b; b.bar = bar; b.x = xb_xcc_id(); b.st = st;
    if (threadIdx.x == 0) (void)xb_add(&bar[XB_XCNT(b.x)], 1u);
    return b;
}
__device__ __forceinline__ void xcd_barrier_complete(unsigned* bar, unsigned x, unsigned& nloc, unsigned& nx) {
    const unsigned G = gridDim.x * gridDim.y * gridDim.z;
    unsigned sum, cnt, mine, sp = 0u;
    for (;;) {
        sum = 0u; cnt = 0u; mine = 0u;
#pragma unroll
        for (unsigned j = 0; j < 16; ++j) { const unsigned c = xb_ld(&bar[XB_XCNT(j)]); sum += c; cnt += (c > 0u) ? 1u : 0u; mine = (j == x) ? c : mine; }
        if (sum == G) break;
        __builtin_amdgcn_s_sleep(1);
        if ((++sp & 255u) == 0u) { if (xb_ld(&bar[XB_TMO])) break; if (sp > XB_SPIN_CAP) { atomicAdd(&bar[XB_TMO], 1u); break; } }
    }
    nloc = mine > 0u ? mine : 1u; nx = cnt > 0u ? cnt : 1u;
}
__device__ __forceinline__ void xcd_barrier(const XcdBarrier& b) {
    asm volatile("s_waitcnt vmcnt(0)" ::: "memory");
    __syncthreads();
    if (threadIdx.x == 0) {
        unsigned* bar = b.bar;
        __builtin_amdgcn_s_waitcnt(0);
        unsigned nloc = b.st[0], nx = b.st[1];
        if (nloc == 0u) { xcd_barrier_complete(bar, b.x, nloc, nx); b.st[0] = nloc; b.st[1] = nx; }
        const unsigned old = xb_add(&bar[XB_XSUB(b.x)], 1u);
        const unsigned gen = old / nloc;
        if (old + 1u == (gen + 1u) * nloc) {
            __builtin_amdgcn_fence(__ATOMIC_RELEASE, "agent");
            asm volatile("s_waitcnt vmcnt(0)" ::: "memory");
            const unsigned og = xb_add(&bar[XB_TOP], 1u);
            const unsigned tg = og / nx;
            if (og + 1u == (tg + 1u) * nx) xb_add(&bar[XB_TOPGEN], 1u);
            else XB_SPIN(xb_ld(&bar[XB_TOPGEN]) == tg, bar);
            __builtin_amdgcn_fence(__ATOMIC_ACQUIRE, "agent");
            xb_add(&bar[XB_XGEN(b.x)], 1u);
            asm volatile("s_waitcnt vmcnt(0)" ::: "memory");
        } else {
            XB_SPIN(xb_ld(&bar[XB_XGEN(b.x)]) == gen, bar);
            __builtin_amdgcn_fence(__ATOMIC_ACQUIRE, "agent");
            asm volatile("s_waitcnt vmcnt(0)" ::: "memory");
        }
    }
    __syncthreads();
}

struct Args {
    const float *x, *c, *ctx, *c_ctx, *norm_w, *w_ada, *b_ada, *w_in, *w_out;
    const float *lam_re, *lam_im, *log_step, *b_re, *b_im, *c_re, *c_im, *s5_d, *w_glu, *b_glu, *pool_w, *pool_scale, *final_norm_w;
    float* out; unsigned char* ws; int ph_lo, ph_hi;
};
struct Ctx {
    LAS unsigned char* lds; int tid, lane, wave, G, wg;
};

__device__ __forceinline__ void p0_transpose_item(const float* W, int K, int N, bf16* WT, LAS float* scr, int item, int lane) {
    const int nblk = N / 32, kb = item / nblk, nb = item % nblk, k0 = 64 * kb, n0 = 32 * nb;
    float ld[32];
#pragma unroll
    for (int i = 0; i < 32; ++i) ld[i] = __builtin_nontemporal_load(W + (size_t)(k0 + 2 * i + (lane >> 5)) * N + n0 + (lane & 31));
#pragma unroll
    for (int i = 0; i < 32; ++i) scr[(2 * i + (lane >> 5)) * 33 + (lane & 31)] = ld[i];
    asm volatile("s_waitcnt lgkmcnt(0)" ::: "memory");
    const int c = lane & 7;
#pragma unroll
    for (int j = 0; j < 4; ++j) { const int n = (lane >> 3) + 8 * j; const LAS float* s = scr + (8 * c) * 33 + n;
        u32x4 o; o.x = cvt_pk_bf16(s[0 * 33], s[1 * 33]); o.y = cvt_pk_bf16(s[2 * 33], s[3 * 33]); o.z = cvt_pk_bf16(s[4 * 33], s[5 * 33]); o.w = cvt_pk_bf16(s[6 * 33], s[7 * 33]);
        __builtin_nontemporal_store(o, (GAS u32x4*)(WT + (size_t)(n0 + n) * K + k0 + 8 * c)); }
    asm volatile("s_waitcnt lgkmcnt(0)" ::: "memory");
}

__device__ __forceinline__ void p0_transpose_item_i8(const float* W, int K, int N, unsigned char* WT, LAS float* scr, int item, int lane, float inv_r) {
    const int nblk = N / 32, pi = item >> 1, kb = 2 * (pi / nblk) + (item & 1), nb = pi % nblk, k0 = 64 * kb, n0 = 32 * nb;
    float ld[32];
#pragma unroll
    for (int i = 0; i < 32; ++i) ld[i] = __builtin_nontemporal_load(W + (size_t)(k0 + 2 * i + (lane >> 5)) * N + n0 + (lane & 31));
#pragma unroll
    for (int i = 0; i < 32; ++i) scr[(2 * i + (lane >> 5)) * 33 + (lane & 31)] = ld[i];
    asm volatile("s_waitcnt lgkmcnt(0)" ::: "memory");
    const int n = lane & 31, hf = lane >> 5; const LAS float* sp = scr + (32 * hf) * 33 + n;
    unsigned w[8];
#pragma unroll
    for (int q = 0; q < 8; ++q) w[q] = pack_i8x4(sp[(4 * q + 0) * 33], sp[(4 * q + 1) * 33], sp[(4 * q + 2) * 33], sp[(4 * q + 3) * 33], inv_r);
    GAS u32x4* dst = (GAS u32x4*)(WT + (size_t)(n0 + n) * K + k0 + 32 * hf);
    dst[0] = (u32x4){w[0], w[1], w[2], w[3]}; dst[1] = (u32x4){w[4], w[5], w[6], w[7]};
    asm volatile("s_waitcnt lgkmcnt(0)" ::: "memory");
}

template <int SET>
__device__ __forceinline__ void p0_convert(const Args& a, const Ctx& F, int gw, int NGW, float r_in, float r_glu) {
    unsigned char* ws = a.ws;
    LAS float* scr = (LAS float*)(F.lds + F.wave * 16384);
    constexpr int I_IN = (DM / 64) * (2 * EI / 32), I_GLU = (EI / 64) * (EI / 32), I_OUT = (EI / 64) * (DM / 32), I_POOL = (2048 / 64) * (2048 / 32);
    if (SET == 0) {
        for (int r = gw; r < I_IN; r += NGW) { if (Q8_L0) p0_transpose_item_i8(a.w_in, DM, 2 * EI, ws + WS_WIN0, scr, r, F.lane, 1.0f / r_in); else p0_transpose_item(a.w_in, DM, 2 * EI, (bf16*)(ws + WS_WIN0), scr, r, F.lane); }
    } else {
        constexpr int NITEMS = I_GLU + 2 * I_OUT + I_IN + 4 * I_POOL;
        struct Desc { const float* src; unsigned char* dst; int K, N, k0, n0, i8; };
        auto decode = [&](int it) __attribute__((always_inline)) { Desc d; int r = it;
            if (r < I_GLU) { d.src = a.w_glu; d.dst = ws + WS_WGLU; d.K = EI; d.N = EI; d.i8 = 1; }
            else if ((r -= I_GLU) < I_OUT) { d.src = a.w_out; d.dst = ws + WS_WOUT0; d.K = EI; d.N = DM; d.i8 = 0; }
            else if ((r -= I_OUT) < I_IN) { d.src = a.w_in + (size_t)DM * 2 * EI; d.dst = ws + WS_WIN1; d.K = DM; d.N = 2 * EI; d.i8 = 0; }
            else if ((r -= I_IN) < 4 * I_POOL) { const int k = r / I_POOL; r -= k * I_POOL; d.src = a.pool_w + (size_t)k * 2048 * 2048; d.dst = ws + WS_WPOOL + (size_t)k * 2048 * 2048 * 2; d.K = 2048; d.N = 2048; d.i8 = 0; }
            else { r -= 4 * I_POOL; d.src = a.w_out + (size_t)EI * DM; d.dst = ws + WS_WOUT1; d.K = EI; d.N = DM; d.i8 = 0; }
            const int nblk = d.N / 32;
            if (d.i8) { const int pi = r >> 1; d.k0 = 64 * (2 * (pi / nblk) + (r & 1)); d.n0 = 32 * (pi % nblk); } else { d.k0 = 64 * (r / nblk); d.n0 = 32 * (r % nblk); }
            return d; };
        static_assert(Q8_L1 == 0, "the converter path assumes a bf16 layer-1 in-projection weight");
        const int lane = F.lane, lr = lane >> 3, lc = 4 * (lane & 7);
        const float inv_rg = 1.0f / r_glu;
#define CV_LOAD(B, itx) do { const int itc_ = (itx) < NITEMS ? (itx) : NITEMS - 1; const Desc q_ = decode(itc_); const float* p_ = q_.src + (size_t)(q_.k0 + lr) * q_.N + q_.n0 + lc; \
        _Pragma("unroll") for (int i = 0; i < 8; ++i) B[i] = __builtin_nontemporal_load((const f32x4*)(p_ + (size_t)(8 * i) * q_.N)); } while (0)
#define CV_FIN(B, itx) do { if ((itx) < NITEMS) { const Desc d = decode(itx); \
        _Pragma("unroll") for (int i = 0; i < 8; ++i) { LAS float* w_ = scr + (8 * i + lr) * 33 + lc; w_[0] = B[i][0]; w_[1] = B[i][1]; w_[2] = B[i][2]; w_[3] = B[i][3]; } \
        asm volatile("s_waitcnt lgkmcnt(0)" ::: "memory"); \
        if (d.i8) { const int n = lane & 31, hf = lane >> 5; const LAS float* sp = scr + (32 * hf) * 33 + n; unsigned w[8]; \
            _Pragma("unroll") for (int q = 0; q < 8; ++q) w[q] = pack_i8x4(sp[(4 * q + 0) * 33], sp[(4 * q + 1) * 33], sp[(4 * q + 2) * 33], sp[(4 * q + 3) * 33], inv_rg); \
            GAS u32x4* dst = (GAS u32x4*)(d.dst + (size_t)(d.n0 + n) * d.K + d.k0 + 32 * hf); \
            dst[0] = (u32x4){w[0], w[1], w[2], w[3]}; dst[1] = (u32x4){w[4], w[5], w[6], w[7]}; \
        } else { const int c = lane & 7; \
            _Pragma("unroll") for (int j = 0; j < 4; ++j) { const int n = (lane >> 3) + 8 * j; const LAS float* sq = scr + (8 * c) * 33 + n; \
                u32x4 o; o.x = cvt_pk_bf16(sq[0 * 33], sq[1 * 33]); o.y = cvt_pk_bf16(sq[2 * 33], sq[3 * 33]); o.z = cvt_pk_bf16(sq[4 * 33], sq[5 * 33]); o.w = cvt_pk_bf16(sq[6 * 33], sq[7 * 33]); \
                __builtin_nontemporal_store(o, (GAS u32x4*)((bf16*)d.dst + (size_t)(d.n0 + n) * d.K + d.k0 + 8 * c)); } } \
        asm volatile("s_waitcnt lgkmcnt(0)" ::: "memory"); } } while (0)
        f32x4 b0[8], b1[8], b2[8];
        int it = gw;
        CV_LOAD(b0, it); CV_LOAD(b1, it + NGW);
        while (it < NITEMS) {
            CV_LOAD(b2, it + 2 * NGW); CV_FIN(b0, it);
            CV_LOAD(b0, it + 3 * NGW); CV_FIN(b1, it + NGW);
            CV_LOAD(b1, it + 4 * NGW); CV_FIN(b2, it + 2 * NGW);
            it += 3 * NGW;
        }
#undef CV_LOAD
#undef CV_FIN
    }
}
__device__ __forceinline__ void p0_prologue(const Args& a, const Ctx& F) {
    unsigned char* ws = a.ws;
    {
        LAS float* sc = (LAS float*)F.lds;
        LAS float* red = (LAS float*)(F.lds + 49152);
        for (int i = F.tid; i < 3 * DM; i += NWAVES * 64) { const int r = i / DM, k = i % DM; const float v = (r < 2) ? a.c[r * DM + k] : a.c_ctx[k]; sc[i] = silu_f(v); }
        __syncthreads();
        float* modp = (float*)(ws + WS_MODP);
        for (int u = F.wg; u < 768; u += F.G) {
            const int layer = u / 384, r = u % 384, kh = r / 192, cb = r % 192;
            const int kbeg = kh * 2048 + F.wave * 256;
            const float* W = a.w_ada + (size_t)layer * DM * 12288 + (size_t)kbeg * 12288 + cb * 64 + F.lane;
            float a0 = 0.f, a1 = 0.f, a2 = 0.f;
#pragma unroll 16
            for (int k = 0; k < 256; ++k) { const float w = __builtin_nontemporal_load(W + (size_t)k * 12288); a0 += sc[kbeg + k] * w; a1 += sc[DM + kbeg + k] * w; a2 += sc[2 * DM + kbeg + k] * w; }
            red[(F.wave * 3 + 0) * 64 + F.lane] = a0; red[(F.wave * 3 + 1) * 64 + F.lane] = a1; red[(F.wave * 3 + 2) * 64 + F.lane] = a2;
            __syncthreads();
            if (F.tid < 192) { const int rr = F.tid / 64, cc = F.tid % 64; float s = 0.f;
#pragma unroll
                for (int w = 0; w < 8; ++w) s += red[(w * 3 + rr) * 64 + cc];
                modp[((size_t)(layer * 2 + kh) * 3 + rr) * 12288 + cb * 64 + cc] = s; }
            __syncthreads();
        }
    }
    const int gw = F.wg * NWAVES + F.wave, NGW = F.G * NWAVES;
    float r_in, r_glu;
    {
        LAS float* rq = (LAS float*)(F.lds + 56000);
        float s0 = 0.f, s1 = 0.f;
#pragma unroll 4
        for (int i = 0; i < 32; ++i) { const float x0 = a.w_in[F.tid + 512 * i], x1 = a.w_glu[F.tid + 512 * i]; s0 += x0 * x0; s1 += x1 * x1; }
        s0 = wave_sum(s0); s1 = wave_sum(s1);
        if (F.lane == 0) { rq[F.wave] = s0; rq[8 + F.wave] = s1; }
        __syncthreads();
        float t0 = 0.f, t1 = 0.f;
#pragma unroll
        for (int w = 0; w < 8; ++w) { t0 += rq[w]; t1 += rq[8 + w]; }
        r_in = WIN8_KSIG * sqrtf(t0 * (1.0f / 16384.0f)); r_glu = WG8_KSIG * sqrtf(t1 * (1.0f / 16384.0f));
        if (F.wg == 0 && F.tid == 0) { ((float*)(ws + WS_QR))[0] = r_in; ((float*)(ws + WS_QR))[1] = r_glu; }
    }
    __syncthreads();
    for (int it = F.wave * F.G + F.wg; it < 2 * NG; it += NGW) {
        LAS f32x2* bbs = (LAS f32x2*)(F.lds + F.wave * 16384); LAS f32x2* lms = bbs + 64 * 16;
        {
            const int p = F.lane;
            const float lre = a.lam_re[it * NP + p], lim = a.lam_im[it * NP + p], dt = __expf(a.log_step[it]);
            const float ar = lre * dt, th = lim * dt;
            const float em1 = expm1f(ar), er = em1 + 1.0f; float sn, cs; sincosf(th, &sn, &cs);
            const float sh = sinf(0.5f * th);
            const float lbr = er * cs, lbi = er * sn;
            const float nr = em1 * cs - 2.0f * sh * sh, ni = lbi;
            const float d2 = lre * lre + lim * lim;
            const float c0r = (nr * lre + ni * lim) / d2, c0i = (ni * lre - nr * lim) / d2;
            ((float2*)(ws + WS_S5L))[it * NP + p] = make_float2(lbr * lbr - lbi * lbi, 2.0f * lbr * lbi);
            lms[p] = (f32x2){lbr, lbi};
            const float* bre = a.b_re + ((size_t)it * NP + p) * NJ; const float* bim = a.b_im + ((size_t)it * NP + p) * NJ;
            float br[16], bi[16], lr_[16], li_[16];
#pragma unroll
            for (int j = 0; j < 16; ++j) { const float x = bre[j], y = bim[j]; br[j] = c0r * x - c0i * y; bi[j] = c0r * y + c0i * x; bbs[p * 16 + j] = (f32x2){br[j], bi[j]};
                lr_[j] = lbr * br[j] - lbi * bi[j]; li_[j] = lbr * bi[j] + lbi * br[j]; }
            bf16* Bf = (bf16*)(ws + WS_S5B) + (size_t)it * 2 * 4 * 64 * 8;
#pragma unroll
            for (int sx = 0; sx < 2; ++sx)
#pragma unroll
                for (int h = 0; h < 2; ++h) {
                    u32x4 wr_, wi_;
                    if (sx == 0) { wr_.x = cvt_pk_bf16(lr_[8 * h + 0], lr_[8 * h + 1]); wr_.y = cvt_pk_bf16(lr_[8 * h + 2], lr_[8 * h + 3]); wr_.z = cvt_pk_bf16(lr_[8 * h + 4], lr_[8 * h + 5]); wr_.w = cvt_pk_bf16(lr_[8 * h + 6], lr_[8 * h + 7]);
                                   wi_.x = cvt_pk_bf16(li_[8 * h + 0], li_[8 * h + 1]); wi_.y = cvt_pk_bf16(li_[8 * h + 2], li_[8 * h + 3]); wi_.z = cvt_pk_bf16(li_[8 * h + 4], li_[8 * h + 5]); wi_.w = cvt_pk_bf16(li_[8 * h + 6], li_[8 * h + 7]); }
                    else         { wr_.x = cvt_pk_bf16(br[8 * h + 0], br[8 * h + 1]); wr_.y = cvt_pk_bf16(br[8 * h + 2], br[8 * h + 3]); wr_.z = cvt_pk_bf16(br[8 * h + 4], br[8 * h + 5]); wr_.w = cvt_pk_bf16(br[8 * h + 6], br[8 * h + 7]);
                                   wi_.x = cvt_pk_bf16(bi[8 * h + 0], bi[8 * h + 1]); wi_.y = cvt_pk_bf16(bi[8 * h + 2], bi[8 * h + 3]); wi_.z = cvt_pk_bf16(bi[8 * h + 4], bi[8 * h + 5]); wi_.w = cvt_pk_bf16(bi[8 * h + 6], bi[8 * h + 7]); }
                    const int blk = 2 * (p >> 5), ln = (p & 31) + 32 * sx;
                    *(u32x4*)(Bf + ((size_t)(h * 4 + blk + 0) * 64 + ln) * 8) = wr_;
                    *(u32x4*)(Bf + ((size_t)(h * 4 + blk + 1) * 64 + ln) * 8) = wi_;
                }
        }
        asm volatile("s_waitcnt lgkmcnt(0)" ::: "memory");
        {
            const int j = F.lane & 15, kq = F.lane >> 4;
            const float* cre = a.c_re + ((size_t)it * NJ + j) * NP; const float* cim = a.c_im + ((size_t)it * NJ + j) * NP;
            bf16* Cf = (bf16*)(ws + WS_S5C) + (size_t)it * 2 * 4 * 64 * 8;
#pragma unroll
            for (int ks = 0; ks < 4; ++ks) { const int p0 = 16 * ks + 4 * kq;
                const f32x4 r4 = *(const f32x4*)(cre + p0), i4 = *(const f32x4*)(cim + p0);
                float o1[8], o2[8];
#pragma unroll
                for (int t = 0; t < 4; ++t) { const f32x2 l = lms[p0 + t]; const float ar_ = r4[t] * l.x - i4[t] * l.y, ai_ = r4[t] * l.y + i4[t] * l.x;
                    const float br_ = ar_ * l.x - ai_ * l.y, bi_ = ar_ * l.y + ai_ * l.x;
                    o1[2 * t] = ar_; o1[2 * t + 1] = -ai_; o2[2 * t] = br_; o2[2 * t + 1] = -bi_; }
                u32x4 w1, w2; w1.x = cvt_pk_bf16(o1[0], o1[1]); w1.y = cvt_pk_bf16(o1[2], o1[3]); w1.z = cvt_pk_bf16(o1[4], o1[5]); w1.w = cvt_pk_bf16(o1[6], o1[7]);
                w2.x = cvt_pk_bf16(o2[0], o2[1]); w2.y = cvt_pk_bf16(o2[2], o2[3]); w2.z = cvt_pk_bf16(o2[4], o2[5]); w2.w = cvt_pk_bf16(o2[6], o2[7]);
                *(u32x4*)(Cf + ((size_t)(0 * 4 + ks) * 64 + F.lane) * 8) = w1; *(u32x4*)(Cf + ((size_t)(1 * 4 + ks) * 64 + F.lane) * 8) = w2; }
            const int jb = 8 * (kq & 1);
            float k0[8], k1[8];
#pragma unroll
            for (int e = 0; e < 8; ++e) { k0[e] = 0.f; k1[e] = 0.f; }
            for (int p = 0; p < NP; ++p) { const float cr = cre[p], ci = cim[p]; const f32x2 l = lms[p]; const float lr2 = cr * l.x - ci * l.y, li2 = cr * l.y + ci * l.x;
#pragma unroll
                for (int e = 0; e < 8; ++e) { const f32x2 b = bbs[p * 16 + jb + e]; k0[e] += cr * b.x - ci * b.y; k1[e] += lr2 * b.x - li2 * b.y; } }
            const bool s0 = (kq >> 1) == 0;
            u32x4 w0, w1;
            w0.x = s0 ? cvt_pk_bf16(k0[0], k0[1]) : 0u; w0.y = s0 ? cvt_pk_bf16(k0[2], k0[3]) : 0u; w0.z = s0 ? cvt_pk_bf16(k0[4], k0[5]) : 0u; w0.w = s0 ? cvt_pk_bf16(k0[6], k0[7]) : 0u;
            w1.x = s0 ? cvt_pk_bf16(k1[0], k1[1]) : cvt_pk_bf16(k0[0], k0[1]); w1.y = s0 ? cvt_pk_bf16(k1[2], k1[3]) : cvt_pk_bf16(k0[2], k0[3]);
            w1.z = s0 ? cvt_pk_bf16(k1[4], k1[5]) : cvt_pk_bf16(k0[4], k0[5]); w1.w = s0 ? cvt_pk_bf16(k1[6], k1[7]) : cvt_pk_bf16(k0[6], k0[7]);
            bf16* Kf = (bf16*)(ws + WS_S5K) + (size_t)it * 2 * 64 * 8;
            *(u32x4*)(Kf + ((size_t)0 * 64 + F.lane) * 8) = w0; *(u32x4*)(Kf + ((size_t)1 * 64 + F.lane) * 8) = w1;
        }
        asm volatile("s_waitcnt lgkmcnt(0)" ::: "memory");
    }
    __syncthreads();
    p0_convert<0>(a, F, gw, NGW, r_in, r_glu);
}

__device__ __forceinline__ float wave_max(float v) {
#pragma unroll
    for (int o = 1; o < 64; o <<= 1) v = __builtin_fmaxf(v, __shfl_xor(v, o));
    return v;
}
template <int NSETS, bool Q8>
__device__ __forceinline__ void norm_mod_phase(const Args& a, const Ctx& F, int layer, const float* xsrc, int nrows) {
    LAS float* T = (LAS float*)F.lds;
    const float* modp = (const float*)(a.ws + WS_MODP) + (size_t)layer * 2 * 3 * 12288;
    const float* bada = a.b_ada + (size_t)layer * 12288; const float* nw = a.norm_w + (size_t)layer * DM;
    for (int i = F.tid; i < NSETS * DM; i += NWAVES * 64) { const int s = i / DM, k = i % DM;
        const float shift = bada[k] + modp[s * 12288 + k] + modp[(3 + s) * 12288 + k];
        const float scale = bada[DM + k] + modp[s * 12288 + DM + k] + modp[(3 + s) * 12288 + DM + k];
        T[(s * 2 + 0) * DM + k] = nw[k] * (1.0f + scale); T[(s * 2 + 1) * DM + k] = shift; }
    __syncthreads();
    bf16* XN = (bf16*)(a.ws + WS_XN);
    const int gw = F.wg * NWAVES + F.wave, NGW = F.G * NWAVES;
    for (int m = gw; m < nrows; m += NGW) {
        const int set = m < SEQ ? 0 : (m < M ? 1 : 2);
        const float* src = m < M ? xsrc + (size_t)m * DM : a.ctx + (size_t)(m - M) * DM;
        const GAS f32x4* xr = (const GAS f32x4*)src + F.lane;
        f32x4 v[16]; float s = 0.f;
#pragma unroll
        for (int j = 0; j < 16; ++j) { v[j] = xr[64 * j]; s += (v[j].x * v[j].x + v[j].y * v[j].y) + (v[j].z * v[j].z + v[j].w * v[j].w); }
        const float rstd = 1.0f / sqrtf(wave_sum(s) * (1.0f / DM) + RMS_EPS);
        const LAS f32x4* TA = (const LAS f32x4*)(T + (set * 2 + 0) * DM) + F.lane; const LAS f32x4* TS = (const LAS f32x4*)(T + (set * 2 + 1) * DM) + F.lane;
        if (Q8) {
            float mx = 0.f;
#pragma unroll
            for (int j = 0; j < 16; ++j) { const f32x4 A = TA[64 * j], S = TS[64 * j]; v[j] = v[j] * rstd * A + S;
                mx = __builtin_fmaxf(__builtin_fmaxf(mx, __builtin_fmaxf(__builtin_fabsf(v[j].x), __builtin_fabsf(v[j].y))), __builtin_fmaxf(__builtin_fabsf(v[j].z), __builtin_fabsf(v[j].w))); }
            mx = __builtin_fmaxf(wave_max(mx), 1e-20f); const float inv = 1.0f / mx;
            if (F.lane == 0) ((float*)(a.ws + WS_RS))[(size_t)m * 32] = mx * (1.0f / Q8v);
            GAS unsigned* o4 = (GAS unsigned*)((unsigned char*)XN + (size_t)m * DM) + F.lane;
#pragma unroll
            for (int j = 0; j < 16; ++j) o4[64 * j] = pack_i8x4(v[j].x, v[j].y, v[j].z, v[j].w, inv);
        } else {
            GAS u32x2* o8 = (GAS u32x2*)(XN + (size_t)m * DM) + F.lane;
#pragma unroll
            for (int j = 0; j < 16; ++j) { const f32x4 A = TA[64 * j], S = TS[64 * j]; const f32x4 y = v[j] * rstd * A + S;
                u32x2 w; w.x = cvt_pk_bf16(y.x, y.y); w.y = cvt_pk_bf16(y.z, y.w); o8[64 * j] = w; }
        }
    }
}
template <bool Q8>
__device__ __forceinline__ void norm_mod_phase_b16(const Args& a, const Ctx& F, int layer, const bf16* xsrc) {
    LAS float* T = (LAS float*)F.lds;
    const float* modp = (const float*)(a.ws + WS_MODP) + (size_t)layer * 2 * 3 * 12288;
    const float* bada = a.b_ada + (size_t)layer * 12288; const float* nw = a.norm_w + (size_t)layer * DM;
    for (int i = F.tid; i < 2 * DM; i += NWAVES * 64) { const int s = i / DM, k = i % DM;
        const float shift = bada[k] + modp[s * 12288 + k] + modp[(3 + s) * 12288 + k];
        const float scale = bada[DM + k] + modp[s * 12288 + DM + k] + modp[(3 + s) * 12288 + DM + k];
        T[(s * 2 + 0) * DM + k] = nw[k] * (1.0f + scale); T[(s * 2 + 1) * DM + k] = shift; }
    __syncthreads();
    bf16* XN = (bf16*)(a.ws + WS_XN);
    const int gw = F.wg * NWAVES + F.wave, NGW = F.G * NWAVES;
    for (int m = gw; m < M; m += NGW) {
        const int set = m < SEQ ? 0 : 1;
        const GAS u32x4* xr = (const GAS u32x4*)(xsrc + (size_t)m * DM) + F.lane;
        u32x4 v[8]; float s = 0.f;
#pragma unroll
        for (int j = 0; j < 8; ++j) { v[j] = xr[64 * j];
            const float a0 = bf_lo(v[j].x), a1 = bf_hi(v[j].x), a2 = bf_lo(v[j].y), a3 = bf_hi(v[j].y), a4 = bf_lo(v[j].z), a5 = bf_hi(v[j].z), a6 = bf_lo(v[j].w), a7 = bf_hi(v[j].w);
            s += ((a0 * a0 + a1 * a1) + (a2 * a2 + a3 * a3)) + ((a4 * a4 + a5 * a5) + (a6 * a6 + a7 * a7)); }
        const float rstd = 1.0f / sqrtf(wave_sum(s) * (1.0f / DM) + RMS_EPS);
        const LAS f32x4* TA = (const LAS f32x4*)(T + (set * 2 + 0) * DM) + 2 * F.lane; const LAS f32x4* TS = (const LAS f32x4*)(T + (set * 2 + 1) * DM) + 2 * F.lane;
        if (Q8) {
            f32x4 y[16]; float mx = 0.f;
#pragma unroll
            for (int j = 0; j < 8; ++j) { const f32x4 A0 = TA[128 * j], A1 = TA[128 * j + 1], S0 = TS[128 * j], S1 = TS[128 * j + 1];
                const f32x4 x0 = (f32x4){bf_lo(v[j].x), bf_hi(v[j].x), bf_lo(v[j].y), bf_hi(v[j].y)}, x1 = (f32x4){bf_lo(v[j].z), bf_hi(v[j].z), bf_lo(v[j].w), bf_hi(v[j].w)};
                y[2 * j] = x0 * rstd * A0 + S0; y[2 * j + 1] = x1 * rstd * A1 + S1;
#pragma unroll
                for (int t = 0; t < 2; ++t) mx = __builtin_fmaxf(__builtin_fmaxf(mx, __builtin_fmaxf(__builtin_fabsf(y[2 * j + t].x), __builtin_fabsf(y[2 * j + t].y))), __builtin_fmaxf(__builtin_fabsf(y[2 * j + t].z), __builtin_fabsf(y[2 * j + t].w))); }
            mx = __builtin_fmaxf(wave_max(mx), 1e-20f); const float inv = 1.0f / mx;
            if (F.lane == 0) ((float*)(a.ws + WS_RS))[(size_t)m * 32] = mx * (1.0f / Q8v);
            GAS u32x2* o8 = (GAS u32x2*)((unsigned char*)XN + (size_t)m * DM) + F.lane;
#pragma unroll
            for (int j = 0; j < 8; ++j) { u32x2 w; w.x = pack_i8x4(y[2 * j].x, y[2 * j].y, y[2 * j].z, y[2 * j].w, inv); w.y = pack_i8x4(y[2 * j + 1].x, y[2 * j + 1].y, y[2 * j + 1].z, y[2 * j + 1].w, inv); o8[64 * j] = w; }
        } else {
            GAS u32x4* o16 = (GAS u32x4*)(XN + (size_t)m * DM) + F.lane;
#pragma unroll
            for (int j = 0; j < 8; ++j) { const f32x4 A0 = TA[128 * j], A1 = TA[128 * j + 1], S0 = TS[128 * j], S1 = TS[128 * j + 1];
                const f32x4 x0 = (f32x4){bf_lo(v[j].x), bf_hi(v[j].x), bf_lo(v[j].y), bf_hi(v[j].y)}, x1 = (f32x4){bf_lo(v[j].z), bf_hi(v[j].z), bf_lo(v[j].w), bf_hi(v[j].w)};
                const f32x4 y0 = x0 * rstd * A0 + S0, y1 = x1 * rstd * A1 + S1;
                u32x4 w; w.x = cvt_pk_bf16(y0.x, y0.y); w.y = cvt_pk_bf16(y0.z, y0.w); w.z = cvt_pk_bf16(y1.x, y1.y); w.w = cvt_pk_bf16(y1.z, y1.w); o16[64 * j] = w; }
        }
    }
}
__device__ __forceinline__ void final_norm_phase(const Args& a, const Ctx& F) {
    const bf16* X2 = (const bf16*)(a.ws + WS_X2);
    const int gw = F.wg * NWAVES + F.wave, NGW = F.G * NWAVES;
    for (int m = gw; m < M; m += NGW) {
        const GAS u32x4* xr = (const GAS u32x4*)(X2 + (size_t)m * DM) + F.lane; const GAS f32x4* wv = (const GAS f32x4*)a.final_norm_w + 2 * F.lane;
        GAS f32x4* orow = (GAS f32x4*)(a.out + (size_t)m * DM) + 2 * F.lane;
        u32x4 v[8]; float s = 0.f;
#pragma unroll
        for (int j = 0; j < 8; ++j) { v[j] = xr[64 * j];
            const float a0 = bf_lo(v[j].x), a1 = bf_hi(v[j].x), a2 = bf_lo(v[j].y), a3 = bf_hi(v[j].y), a4 = bf_lo(v[j].z), a5 = bf_hi(v[j].z), a6 = bf_lo(v[j].w), a7 = bf_hi(v[j].w);
            s += ((a0 * a0 + a1 * a1) + (a2 * a2 + a3 * a3)) + ((a4 * a4 + a5 * a5) + (a6 * a6 + a7 * a7)); }
        const float rstd = 1.0f / sqrtf(wave_sum(s) * (1.0f / DM) + RMS_EPS);
#pragma unroll
        for (int j = 0; j < 8; ++j) {
            const f32x4 x0 = (f32x4){bf_lo(v[j].x), bf_hi(v[j].x), bf_lo(v[j].y), bf_hi(v[j].y)}, x1 = (f32x4){bf_lo(v[j].z), bf_hi(v[j].z), bf_lo(v[j].w), bf_hi(v[j].w)};
            orow[128 * j] = x0 * rstd * wv[128 * j]; orow[128 * j + 1] = x1 * rstd * wv[128 * j + 1]; }
    }
}

__device__ __forceinline__ f32x2 gelu2(f32x2 v) {
    const f32x2 t = v * v, w = t * (-0.10294324f) + (-2.3022082f), a = v * w;
    f32x2 e; e.x = __builtin_amdgcn_exp2f(a.x); e.y = __builtin_amdgcn_exp2f(a.y);
    const f32x2 q = e + 1.0f; f32x2 r; r.x = __builtin_amdgcn_rcpf(q.x); r.y = __builtin_amdgcn_rcpf(q.y);
    return v * r;
}
template <bool REV>
__device__ __forceinline__ void s5_latent(const bf16* U, bf16* YA, unsigned char* Y8, size_t gbase, const bf16x8 (&Bf)[2][4], const bf16x8 (&Cf)[2][4], const bf16x8 (&Kf)[2],
                                          float lr, float li, float hre, float him, LAS unsigned char* my, f32x4 dsk, int lane) {
    constexpr int SG = REV ? -1 : 1;
    constexpr int TSTEP = SG * 64 * 16, CSTEP16 = SG * 32 * 16, SSTEP = SG * 16;
    const float nli = -li;
    const int nl = lane & 31, hl = lane >> 5, tk = lane & 15, kq = lane >> 4;
    const bf16* pA = U + gbase + SG * (2 * nl + hl) * 16;
    const bf16* pB = U + gbase + SG * (2 * tk + (kq >> 1)) * 16 + 8 * (kq & 1);
    const bf16* pU = U + gbase + SG * (2 * tk) * 16 + 4 * kq;
    bf16* pY = YA + gbase + SG * (2 * tk) * 16 + 4 * kq;
    bf16x8 A0 = *(const bf16x8*)pA, A1 = *(const bf16x8*)(pA + 8);
    bf16x8 Ub[2]; Ub[0] = *(const bf16x8*)pB; Ub[1] = *(const bf16x8*)(pB + CSTEP16);
    u32x2 pv[2][2], uv[2][2];
#pragma unroll
    for (int th = 0; th < 2; ++th)
#pragma unroll
        for (int sx = 0; sx < 2; ++sx) { pv[th][sx] = (u32x2){0u, 0u}; uv[th][sx] = (u32x2){0u, 0u}; }
    const f32x2 dsk01 = (f32x2){dsk[0], dsk[1]}, dsk23 = (f32x2){dsk[2], dsk[3]};
    LAS unsigned* wbase = (LAS unsigned*)(my + ((lane & 3) << 2));
    for (int tile = 0; tile < 128; ++tile) {
        const bool second = tile >= 64;
        if (tile == 64) {
            asm volatile("s_waitcnt vmcnt(0)" ::: "memory"); __syncthreads();
            __builtin_amdgcn_fence(__ATOMIC_ACQUIRE, "agent"); asm volatile("s_waitcnt vmcnt(0)" ::: "memory");
#pragma unroll
            for (int th = 0; th < 2; ++th)
#pragma unroll
                for (int sx = 0; sx < 2; ++sx) { pv[th][sx] = *(const u32x2*)(pY + th * CSTEP16 + sx * SSTEP); uv[th][sx] = *(const u32x2*)(pU + th * CSTEP16 + sx * SSTEP); }
        }
        const int adv = (tile + 1 < 128) ? TSTEP : 0;
        f32x16 acc[4];
#pragma unroll
        for (int i = 0; i < 4; ++i) { acc[i] = (f32x16){0.f,0.f,0.f,0.f,0.f,0.f,0.f,0.f,0.f,0.f,0.f,0.f,0.f,0.f,0.f,0.f};
            acc[i] = __builtin_amdgcn_mfma_f32_32x32x16_bf16(A0, Bf[0][i], acc[i], 0, 0, 0); acc[i] = __builtin_amdgcn_mfma_f32_32x32x16_bf16(A1, Bf[1][i], acc[i], 0, 0, 0); }
        A0 = *(const bf16x8*)(pA + adv); A1 = *(const bf16x8*)(pA + adv + 8);
        float sre0[16], sre1[16], sim0[16], sim1[16];
#pragma unroll
        for (int r = 0; r < 16; ++r) {
            auto s0 = __builtin_amdgcn_permlane32_swap(__float_as_uint(acc[0][r]), __float_as_uint(acc[2][r]), false, false);
            auto s1 = __builtin_amdgcn_permlane32_swap(__float_as_uint(acc[1][r]), __float_as_uint(acc[3][r]), false, false);
            sre0[r] = __uint_as_float(s0[0]); sre1[r] = __uint_as_float(s0[1]); sim0[r] = __uint_as_float(s1[0]); sim1[r] = __uint_as_float(s1[1]); }
#pragma unroll
        for (int i2 = 0; i2 < 16; ++i2) {
            unsigned hw[2];
#pragma unroll
            for (int e = 0; e < 2; ++e) { const int i = 2 * i2 + e;
                const int r = (i & 3) + 4 * (i >> 3); const bool up = (i >> 2) & 1;
                const float sr = up ? sre1[r] : sre0[r], si = up ? sim1[r] : sim0[r];
                hw[e] = cvt_pk_bf16(hre, him);
                const float nre = __builtin_fmaf(lr, hre, __builtin_fmaf(nli, him, sr)), nim = __builtin_fmaf(lr, him, __builtin_fmaf(li, hre, si)); hre = nre; him = nim; }
            LAS unsigned* wp = wbase + (2 * i2) * 64 + ((((lane >> 2) ^ (i2 & 15)) << 2));
            wp[0] = hw[0]; wp[64] = hw[1];
        }
#pragma unroll
        for (int th = 0; th < 2; ++th) {
            bf16x8 Hf[4];
#pragma unroll
            for (int ks = 0; ks < 4; ++ks) Hf[ks] = *(const LAS bf16x8*)(my + (16 * th + tk) * 256 + ((((4 * ks + kq) ^ ((8 * th + (tk >> 1)) & 15))) << 4));
#pragma unroll
            for (int sx = 0; sx < 2; ++sx) {
                f32x4 y = (f32x4){0.f, 0.f, 0.f, 0.f};
                y = __builtin_amdgcn_mfma_f32_16x16x32_bf16(Kf[sx], Ub[th], y, 0, 0, 0);
#pragma unroll
                for (int ks = 0; ks < 4; ++ks) y = __builtin_amdgcn_mfma_f32_16x16x32_bf16(Cf[sx][ks], Hf[ks], y, 0, 0, 0);
                bf16* yo = pY + th * CSTEP16 + sx * SSTEP;
                if (!second) { u32x2 w; w.x = cvt_pk_bf16_mfma(y[0], y[1]); w.y = cvt_pk_bf16(y[2], y[3]); *(u32x2*)yo = w; }
                else { const u32x2 p = pv[th][sx], u = uv[th][sx];
                    const f32x2 v01 = (f32x2){y[0], y[1]} + (f32x2){bf_lo(p.x), bf_hi(p.x)} + dsk01 * (f32x2){bf_lo(u.x), bf_hi(u.x)};
                    const f32x2 v23 = (f32x2){y[2], y[3]} + (f32x2){bf_lo(p.y), bf_hi(p.y)} + dsk23 * (f32x2){bf_lo(u.y), bf_hi(u.y)};
                    const f32x2 o01 = gelu2(v01), o23 = gelu2(v23);
                    u32x2 w; w.x = cvt_pk_bf16(o01.x, o01.y); w.y = cvt_pk_bf16(o23.x, o23.y); *(u32x2*)yo = w;
                    { const unsigned x8 = pack_i8x4(o01.x, o01.y, o23.x, o23.y, 1.0f / YA8_R);
                      *(unsigned*)(Y8 + (yo - YA)) = x8; }
                    pv[th][sx] = *(const u32x2*)(yo + adv); uv[th][sx] = *(const u32x2*)(pU + th * CSTEP16 + sx * SSTEP + adv); }
            }
            Ub[th] = *(const bf16x8*)(pB + th * CSTEP16 + adv);
        }
        pA += adv; pB += adv; pU += adv; pY += adv;
    }
}
__device__ __forceinline__ void s5_phase(const Args& a, const Ctx& F) {
    unsigned char* ws = a.ws;
    const int b = F.wg >> 7, gq = F.wg & 127, d = F.wave >> 2, g = gq * 4 + (F.wave & 3), dg = d * NG + g, lane = F.lane;
    const bf16* U = (const bf16*)(ws + WS_U); bf16* YA = (bf16*)(ws + WS_YA); const float* UCP = (const float*)(ws + WS_UCP);
    bf16x8 Bf[2][4], Cf[2][4], Kf[2];
#pragma unroll
    for (int sx = 0; sx < 2; ++sx) {
#pragma unroll
        for (int i = 0; i < 4; ++i) { Bf[sx][i] = *(const bf16x8*)((const bf16*)(ws + WS_S5B) + ((size_t)((dg * 2 + sx) * 4 + i) * 64 + lane) * 8); Cf[sx][i] = *(const bf16x8*)((const bf16*)(ws + WS_S5C) + ((size_t)((dg * 2 + sx) * 4 + i) * 64 + lane) * 8); }
        Kf[sx] = *(const bf16x8*)((const bf16*)(ws + WS_S5K) + ((size_t)(dg * 2 + sx) * 64 + lane) * 8); }
    const float2 lam2 = ((const float2*)(ws + WS_S5L))[dg * NP + lane];
    const float lr = lam2.x, li = lam2.y, nli = -lam2.y;
    float hre = 0.f, him = 0.f;
    const int nl = lane & 31, hl = lane >> 5, tk = lane & 15, kq = lane >> 4;
    LAS unsigned char* my = F.lds + F.wave * 8192;
    const f32x4 dsk = *(const f32x4*)(a.s5_d + 16 * g + 4 * kq);
    const int chan0 = 16 * g;
    const size_t lat0 = (size_t)b * SEQ;
    const int sgn = d ? -1 : 1;
#define S5_STATE_IN(A0_, A1_) \
        f32x16 acc[4]; \
        _Pragma("unroll") for (int i = 0; i < 4; ++i) { acc[i] = (f32x16){0.f,0.f,0.f,0.f,0.f,0.f,0.f,0.f,0.f,0.f,0.f,0.f,0.f,0.f,0.f,0.f}; \
            acc[i] = __builtin_amdgcn_mfma_f32_32x32x16_bf16(A0_, Bf[0][i], acc[i], 0, 0, 0); acc[i] = __builtin_amdgcn_mfma_f32_32x32x16_bf16(A1_, Bf[1][i], acc[i], 0, 0, 0); } \
        float sre0[16], sre1[16], sim0[16], sim1[16]; \
        _Pragma("unroll") for (int r = 0; r < 16; ++r) { \
            auto s0 = __builtin_amdgcn_permlane32_swap(__float_as_uint(acc[0][r]), __float_as_uint(acc[2][r]), false, false); \
            auto s1 = __builtin_amdgcn_permlane32_swap(__float_as_uint(acc[1][r]), __float_as_uint(acc[3][r]), false, false); \
            sre0[r] = __uint_as_float(s0[0]); sre1[r] = __uint_as_float(s0[1]); sim0[r] = __uint_as_float(s1[0]); sim1[r] = __uint_as_float(s1[1]); }
    for (int tile = 0; tile < 4; ++tile) {
        bf16x8 A01[2];
#pragma unroll
        for (int sx = 0; sx < 2; ++sx) {
            const int q = tile * 64 + 2 * nl + hl, t = d ? (CTXL - 1 - q) : q;
            const float* p0 = UCP + (size_t)(b * CTXL + t) * EI + chan0 + 8 * sx;
            f32x4 lo = *(const f32x4*)p0, hi = *(const f32x4*)(p0 + 4);
#pragma unroll
            for (int k = 1; k < 4; ++k) { lo += *(const f32x4*)(p0 + (size_t)k * MC * EI); hi += *(const f32x4*)(p0 + (size_t)k * MC * EI + 4); }
            u32x4 w; w.x = cvt_pk_bf16(lo[0], lo[1]); w.y = cvt_pk_bf16(lo[2], lo[3]); w.z = cvt_pk_bf16(hi[0], hi[1]); w.w = cvt_pk_bf16(hi[2], hi[3]);
            A01[sx] = __builtin_bit_cast(bf16x8, w);
        }
        S5_STATE_IN(A01[0], A01[1])
#pragma unroll
        for (int i = 0; i < 32; ++i) {
            const int r = (i & 3) + 4 * (i >> 3); const bool up = (i >> 2) & 1;
            const float sr = up ? sre1[r] : sre0[r], si = up ? sim1[r] : sim0[r];
            const float nre = __builtin_fmaf(lr, hre, __builtin_fmaf(nli, him, sr)), nim = __builtin_fmaf(lr, him, __builtin_fmaf(li, hre, si)); hre = nre; him = nim;
        }
    }
    const size_t gbase = ((size_t)(b * NG + g) * SEQ + (d ? SEQ - 1 : 0)) * 16;
    unsigned char* Y8 = ws + WS_YA8;
    if (d) s5_latent<true>(U, YA, Y8, gbase, Bf, Cf, Kf, lr, li, hre, him, my, dsk, lane);
    else s5_latent<false>(U, YA, Y8, gbase, Bf, Cf, Kf, lr, li, hre, him, my, dsk, lane);
#undef S5_STATE_IN
}

template <int W>
__device__ __forceinline__ void pool_item(const Ctx& F, const bf16* Ub, bf16* Db, int r0, int nr) {
    constexpr int HW = W / 2, NS = W + 2;
    LAS f32x2* buf = (LAS f32x2*)F.lds;
    for (int i = F.tid; i < 2048; i += NWAVES * 64) { const int bi = i >> 10, rem = i & 1023, cp = rem >> 6, ln = rem & 63; buf[(bi * 80 + (cp < 8 ? cp : cp + 64)) * 64 + ln] = (f32x2){0.f, 0.f}; }
    const int c0 = 8 * F.wave, lane = F.lane;
    f32x2 Vv[8];
#pragma unroll
    for (int j = 0; j < 8; ++j) Vv[j] = (f32x2){0.f, 0.f};
    float icc[8];
#pragma unroll
    for (int j = 0; j < 8; ++j) { const int c = c0 + j, clo = c - HW > 0 ? c - HW : 0, chi = c + HW < 64 ? c + HW : 64; icc[j] = 1.0f / (float)(chi - clo); }
    unsigned ring[NS][8];
    const int rs = r0 - W + 1, re = r0 + nr;
#define POOL_LOAD(slot_, r_) do { int e_ = (r_) + HW - 1; e_ = e_ < 0 ? 0 : (e_ > 127 ? 127 : e_); \
        _Pragma("unroll") for (int j = 0; j < 8; ++j) ring[slot_][j] = *(const GAS unsigned*)(Ub + ((size_t)e_ * 64 + c0 + j) * EI); } while (0)
    POOL_LOAD(0, rs); POOL_LOAD(1, rs + 1);
    __syncthreads();
    for (int base = rs; base < re; base += NS) {
#pragma unroll
        for (int u = 0; u < NS; ++u) {
            const int r = base + u;
            if (r < re) {
                POOL_LOAD((u + 2) % NS, r + 2);
                const int e = r + HW - 1;
                const float me = (e >= 0 && e < 128) ? 1.0f : 0.0f, ml = (r >= r0 && r - HW >= 0) ? 1.0f : 0.0f;
#pragma unroll
                for (int j = 0; j < 8; ++j) { Vv[j].x += me * bf_lo(ring[u][j]); Vv[j].y += me * bf_hi(ring[u][j]); }
                if (r >= r0) {
                    LAS f32x2* row = buf + ((r & 1) * 80 + 8) * 64 + lane;
#pragma unroll
                    for (int j = 0; j < 8; ++j) row[(c0 + j) * 64] = Vv[j];
                    asm volatile("s_waitcnt lgkmcnt(0)" ::: "memory"); __builtin_amdgcn_s_barrier(); asm volatile("" ::: "memory");
                    const int rlo = r - HW > 0 ? r - HW : 0, rhi = r + HW < 128 ? r + HW : 128; const float icr = 1.0f / (float)(rhi - rlo);
                    f32x2 h = (f32x2){0.f, 0.f};
#pragma unroll
                    for (int c = -HW; c < HW; ++c) h += row[(c0 + c) * 64];
#pragma unroll
                    for (int j = 0; j < 8; ++j) {
                        const float ic = icr * icc[j]; const unsigned m = ring[(u + NS - HW + 1) % NS][j];
                        *(GAS unsigned*)(Db + ((size_t)r * 64 + c0 + j) * EI) = cvt_pk_bf16(h.x * ic - bf_lo(m), h.y * ic - bf_hi(m));
                        h += row[(c0 + j + HW) * 64] - row[(c0 + j - HW) * 64];
                    }
#pragma unroll
                    for (int j = 0; j < 8; ++j) { const unsigned l = ring[(u + NS - W + 1) % NS][j]; Vv[j].x -= ml * bf_lo(l); Vv[j].y -= ml * bf_hi(l); }
                }
            }
        }
    }
#undef POOL_LOAD
    __syncthreads();
}
__device__ __forceinline__ void pool_phase(const Args& a, const Ctx& F) {
    const bf16* U = (const bf16*)(a.ws + WS_U); bf16* D = (bf16*)(a.ws + WS_YA);
    for (int it = F.wg; it < 256; it += F.G) {
        const int b = it >> 7, cb = (it >> 1) & 63, seg = it & 1, k = cb >> 4;
        const size_t base = (size_t)b * SEQ * EI + (size_t)cb * 128 + 2 * F.lane;
        if (k == 0) pool_item<2>(F, U + base, D + base, seg * 64, 64);
        else if (k == 1) pool_item<4>(F, U + base, D + base, seg * 64, 64);
        else if (k == 2) pool_item<8>(F, U + base, D + base, seg * 64, 64);
        else pool_item<16>(F, U + base, D + base, seg * 64, 64);
    }
}

__global__ void __launch_bounds__(NWAVES * 64, 2) trunk_fwd(Args a) {
    extern __shared__ __attribute__((aligned(16))) unsigned char lds_raw[];
    Ctx F; F.lds = (LAS unsigned char*)lds_raw; F.tid = threadIdx.x; F.lane = F.tid & 63; F.wave = __builtin_amdgcn_readfirstlane(F.tid >> 6);
    F.G = gridDim.x; F.wg = blockIdx.x;
    volatile LAS unsigned* MISC = (volatile LAS unsigned*)(F.lds + MISC_OFF);
    if (F.tid < 64) MISC[F.tid] = 0u;
    __syncthreads();
    unsigned* ctl = (unsigned*)(a.ws + WS_CTL);
    XcdBarrier bar; bar.bar = ctl + CW_BAR; bar.x = 0; bar.st = nullptr;
    if (MK_N_LAUNCHES == 1) bar = xcd_barrier_post(ctl + CW_BAR, MISC + 8);
    const int lo = a.ph_lo, hi = a.ph_hi;
#ifndef PHASE_MASK
#define PHASE_MASK 0xFFF
#endif
#define IN(k) (((PHASE_MASK >> (k)) & 1) && lo <= (k) && (k) < hi)
#define SEAM(k) do { if (IN(k) && IN((k) + 1)) { XcdBarrier b_; b_.bar = (unsigned*)(a.ws + WS_CTL) + CW_BAR; b_.x = xb_xcc_id(); b_.st = (volatile LAS unsigned*)(F.lds + MISC_OFF) + 8; xcd_barrier(b_); } } while (0)
#ifndef PHASE_REPS
#define PHASE_REPS {1,1,1,1,1,1,1,1,1,1,1,1}
#endif
    constexpr int REP[N_PHASES] = PHASE_REPS;
#define REPEAT(k) for (int rep_ = 0; rep_ < REP[k]; ++rep_)
#define REPSYNC(k) do { if (rep_ + 1 < REP[k]) xcd_barrier(bar); } while (0)
    unsigned char* ws = a.ws;
    const float* modp = (const float*)(ws + WS_MODP);

    if (IN(0)) REPEAT(0) { F.lane = lane_id_asm(); F.tid = F.wave * 64 + F.lane; p0_prologue(a, F); REPSYNC(0); } SEAM(0);
    if (IN(1)) REPEAT(1) { F.lane = lane_id_asm(); F.tid = F.wave * 64 + F.lane; norm_mod_phase<3, Q8_L0 != 0>(a, F, 0, a.x, MT); REPSYNC(1); } SEAM(1);
    if (IN(2)) REPEAT(2) { F.lane = lane_id_asm(); F.tid = F.wave * 64 + F.lane;
        constexpr int KD = Q8_L0 ? DM / 2 : DM;
        if (F.wg < NGEMM_P2) {
        pg8::Gemm g{(const bf16*)(ws + WS_XN), (const bf16*)(ws + WS_WIN0), KD, KD, KD, 0, 0, 0}; pg8::StaticOrder S{64, 64, NGEMM_P2, F.wg};
        pg8::EpiInProj<Q8_L0 != 0> E{(bf16*)(ws + WS_U), (bf16*)(ws + WS_SZ), 1, (const float*)(ws + WS_RS), (const float*)(ws + WS_QR)};
        pg8::gemm_phase(F.lds, g, S, E, F.wave);
        pg8::Gemm gc{(const bf16*)(ws + WS_XN), (const bf16*)(ws + WS_WIN0), KD, KD, KD / 4, (size_t)(KD / 4), (size_t)(KD / 4), 0}; pg8::CtxOrder Sc{NGEMM_P2, F.wg};
        pg8::EpiCtx<Q8_L0 != 0> Ec{(float*)(ws + WS_UCP), (const float*)(ws + WS_RS), (const float*)(ws + WS_QR)};
        pg8::gemm_phase(F.lds, gc, Sc, Ec, F.wave);
        } else { const float r_glu = ((const float*)(ws + WS_QR))[1]; p0_convert<1>(a, F, (F.wg - NGEMM_P2) * NWAVES + F.wave, (F.G - NGEMM_P2) * NWAVES, 1.0f, r_glu); }
        REPSYNC(2);
    } SEAM(2);
    if (IN(3)) REPEAT(3) { F.lane = lane_id_asm(); F.tid = F.wave * 64 + F.lane; s5_phase(a, F); REPSYNC(3); } SEAM(3);
    if (IN(4)) REPEAT(4) { F.lane = lane_id_asm(); F.tid = F.wave * 64 + F.lane;
        pg8::Gemm g{(const bf16*)(ws + WS_YA8), (const bf16*)(ws + WS_WGLU), EI / 2, EI / 2, EI / 2, 0, 0, 2}; pg8::StaticOrder S{64, 32, F.G, F.wg};
        pg8::EpiGlu E{(const bf16*)(ws + WS_YA), (const bf16*)(ws + WS_SZ), (bf16*)(ws + WS_U), a.b_glu, (const float*)(ws + WS_QR)};
        pg8::gemm_phase(F.lds, g, S, E, F.wave); REPSYNC(4);
    } SEAM(4);
    if (IN(5)) REPEAT(5) { F.lane = lane_id_asm(); F.tid = F.wave * 64 + F.lane;
        pg8::Gemm g{(const bf16*)(ws + WS_U), (const bf16*)(ws + WS_WOUT0), EI, EI, EI, 0, 0, 0}; pg8::StaticOrder S{64, 16, F.G, F.wg};
        pg8::EpiOut<false> E{a.x, (bf16*)(ws + WS_X1), modp, modp + 3 * 12288, a.b_ada + 8192};
        pg8::gemm_phase(F.lds, g, S, E, F.wave); REPSYNC(5);
    } SEAM(5);
    if (IN(6)) REPEAT(6) { F.lane = lane_id_asm(); F.tid = F.wave * 64 + F.lane; norm_mod_phase_b16<Q8_L1 != 0>(a, F, 1, (const bf16*)(ws + WS_X1)); REPSYNC(6); } SEAM(6);
    if (IN(7)) REPEAT(7) { F.lane = lane_id_asm(); F.tid = F.wave * 64 + F.lane;
        constexpr int KD = Q8_L1 ? DM / 2 : DM;
        pg8::Gemm g{(const bf16*)(ws + WS_XN), (const bf16*)(ws + WS_WIN1), KD, KD, KD, 0, 0, 0}; pg8::StaticOrder S{64, 64, F.G, F.wg};
        pg8::EpiInProj<Q8_L1 != 0> E{(bf16*)(ws + WS_U), (bf16*)(ws + WS_SZ), 0, (const float*)(ws + WS_RS), (const float*)(ws + WS_QR)};
        pg8::gemm_phase(F.lds, g, S, E, F.wave); REPSYNC(7);
    } SEAM(7);
    if (IN(8)) REPEAT(8) { F.lane = lane_id_asm(); F.tid = F.wave * 64 + F.lane; pool_phase(a, F); REPSYNC(8); } SEAM(8);
    if (IN(9)) REPEAT(9) { F.lane = lane_id_asm(); F.tid = F.wave * 64 + F.lane;
        pg8::Gemm g{(const bf16*)(ws + WS_YA), (const bf16*)(ws + WS_WPOOL), EI, 2048, 2048, 2048, (size_t)2048 * 2048, 0}; pg8::PoolOrder S{F.G, F.wg};
        pg8::EpiPool E{(const bf16*)(ws + WS_SZ), (bf16*)(ws + WS_U), a.pool_scale};
        pg8::gemm_phase(F.lds, g, S, E, F.wave); REPSYNC(9);
    } SEAM(9);
    if (IN(10)) REPEAT(10) { F.lane = lane_id_asm(); F.tid = F.wave * 64 + F.lane;
        pg8::Gemm g{(const bf16*)(ws + WS_U), (const bf16*)(ws + WS_WOUT1), EI, EI, EI, 0, 0, 0}; pg8::StaticOrder S{64, 16, F.G, F.wg};
        pg8::EpiOut<true> E{(const bf16*)(ws + WS_X1), (bf16*)(ws + WS_X2), modp + 6 * 12288, modp + 9 * 12288, a.b_ada + 12288 + 8192};
        pg8::gemm_phase(F.lds, g, S, E, F.wave); REPSYNC(10);
    } SEAM(10);
    if (IN(11)) REPEAT(11) { F.lane = lane_id_asm(); F.tid = F.wave * 64 + F.lane; final_norm_phase(a, F); }
#undef IN
#undef SEAM
}

extern "C" void kernel_launch(void* const* d_in, const int* in_sizes, int n_in, void* d_out, int out_size, void* d_ws, size_t ws_size, hipStream_t stream) {
    static int grid = 0;
    if (grid == 0) {
        if (n_in != 22 || in_sizes[0] != M * DM || out_size != M * DM || ws_size < WS_END) { fprintf(stderr, "kernel_launch: unexpected shapes (n_in %d, in0 %d, out %d, ws %zu); nothing launched\n", n_in, n_in > 0 ? in_sizes[0] : -1, out_size, ws_size); grid = -1; return; }
        int dev = 0, cus = 0, per_cu = 0;
        if (hipGetDevice(&dev) != hipSuccess || hipDeviceGetAttribute(&cus, hipDeviceAttributeMultiprocessorCount, dev) != hipSuccess) { grid = -1; return; }
        if (hipFuncSetAttribute((const void*)trunk_fwd, hipFuncAttributeMaxDynamicSharedMemorySize, LDS_BYTES) != hipSuccess) { fprintf(stderr, "kernel_launch: hipFuncSetAttribute failed\n"); grid = -1; return; }
        if (hipOccupancyMaxActiveBlocksPerMultiprocessor(&per_cu, (const void*)trunk_fwd, NWAVES * 64, LDS_BYTES) != hipSuccess || per_cu < 1) { fprintf(stderr, "kernel_launch: occupancy query reports %d workgroups per CU\n", per_cu); }
        (void)hipGetLastError();
        grid = cus;
        if (grid != 256) { fprintf(stderr, "kernel_launch: built for 256 CUs, device has %d\n", cus); grid = -1; return; }
    }
    if (grid < 0) return;
    (void)hipMemsetAsync((char*)d_ws + WS_CTL, 0, CTL_ZERO_BYTES, stream);
    Args a{};
    const float* const* in = (const float* const*)d_in;
    a.x = in[0]; a.c = in[1]; a.ctx = in[2]; a.c_ctx = in[3]; a.norm_w = in[4]; a.w_ada = in[5]; a.b_ada = in[6]; a.w_in = in[7]; a.w_out = in[8];
    a.lam_re = in[9]; a.lam_im = in[10]; a.log_step = in[11]; a.b_re = in[12]; a.b_im = in[13]; a.c_re = in[14]; a.c_im = in[15]; a.s5_d = in[16];
    a.w_glu = in[17]; a.b_glu = in[18]; a.pool_w = in[19]; a.pool_scale = in[20]; a.final_norm_w = in[21];
    a.out = (float*)d_out; a.ws = (unsigned char*)d_ws;
    if (MK_N_LAUNCHES == 1) { a.ph_lo = 0; a.ph_hi = N_PHASES; hipLaunchKernelGGL(trunk_fwd, dim3(grid), dim3(NWAVES * 64), LDS_BYTES, stream, a); }
    else for (int p = 0; p < N_PHASES; ++p) { a.ph_lo = p; a.ph_hi = p + 1; hipLaunchKernelGGL(trunk_fwd, dim3(grid), dim3(NWAVES * 64), LDS_BYTES, stream, a); }
}
```
